# Optimizing an MI355X kernel written in HIP

```python
import math
import jax, jax.numpy as jnp
from jax import lax
import numpy as np

D_MODEL = 1024
BATCH = 16
SEQ = 4096
DEPTH = 1

HEAD_DIM = 64
N_HEADS_DIL = 8
DIL_PATTERNS = ((128, 1), (512, 4), (2048, 16))
ROPE_DIM_DIL = HEAD_DIM // 4
ROPE_THETA = 500000.0
ATTN_BLOCK = 128
N_HEADS_MLA = 8
Q_LORA = 384
KV_LORA = 128
QK_NOPE = 64
QK_ROPE = 32
V_HEAD = 64
DIL_WIDTH = N_HEADS_DIL * HEAD_DIM
MLA_WIDTH = N_HEADS_MLA * V_HEAD
MIX_WIDTH = DIL_WIDTH + MLA_WIDTH
IN_SPLITS = (DIL_WIDTH, 2 * DIL_WIDTH, 3 * DIL_WIDTH,
             3 * DIL_WIDTH + Q_LORA, 3 * DIL_WIDTH + Q_LORA + KV_LORA)
IN_WIDTH = 3 * DIL_WIDTH + Q_LORA + KV_LORA + QK_ROPE
N_EXPERTS = 256
TOP_K = 8
N_GROUP = 8
TOPK_GROUP = 4
EXPERT_FF = 256
SHARED_FF = 256
ROUTED_SCALE = 2.5
EXPERT_BLOCK = 128
DEEPNORM_ALPHA = (2.0 * DEPTH) ** 0.25
DEEPNORM_BETA = (8.0 * DEPTH) ** -0.25
LN_EPS = 1e-5
RMS_EPS = 1e-6
NEG = -1e30

kernel_name = "hymba_dilated_mla_moe_deepnorm"


def _rmsnorm(x, g):
    xf = x.astype(jnp.float32)
    y = xf * lax.rsqrt(jnp.mean(xf * xf, axis=-1, keepdims=True) + RMS_EPS)
    return (y * g.astype(jnp.float32)).astype(x.dtype)


def _layernorm(x, g, b):
    xf = x.astype(jnp.float32)
    mu = jnp.mean(xf, axis=-1, keepdims=True)
    var = jnp.mean(jnp.square(xf - mu), axis=-1, keepdims=True)
    y = (xf - mu) * lax.rsqrt(var + LN_EPS) * g.astype(jnp.float32) + b.astype(jnp.float32)
    return y.astype(x.dtype)


def _rope_table(seq, dim):
    inv = ROPE_THETA ** (-jnp.arange(0, dim, 2, dtype=jnp.float32) / dim)
    ang = jnp.arange(seq, dtype=jnp.float32)[:, None] * inv[None, :]
    return jnp.cos(ang), jnp.sin(ang)


def _apply_rope(x, cos, sin):
    half = x.shape[-1] // 2
    xf = x.astype(jnp.float32)
    x1, x2 = xf[..., :half], xf[..., half:]
    c, s = cos[None, :, None, :], sin[None, :, None, :]
    return jnp.concatenate([x1 * c - x2 * s, x2 * c + x1 * s], axis=-1).astype(x.dtype)


def _partial_rope(x, cos, sin):
    return jnp.concatenate([_apply_rope(x[..., :ROPE_DIM_DIL], cos, sin),
                            x[..., ROPE_DIM_DIL:]], axis=-1)


def _dilated_window_attention(q, k, v, window, dilation):
    B, S, H, Dh = q.shape
    d = dilation
    W = window // d
    L = S // d
    nb = -(-L // ATTN_BLOCK)
    Lp = nb * ATTN_BLOCK
    qs = q.reshape(B, L, d, H, Dh)
    ks = k.reshape(B, L, d, H, Dh)
    vs = v.reshape(B, L, d, H, Dh)
    qs = jnp.pad(qs, ((0, 0), (0, Lp - L), (0, 0), (0, 0), (0, 0)))
    ks = jnp.pad(ks, ((0, 0), (W, Lp - L), (0, 0), (0, 0), (0, 0)))
    vs = jnp.pad(vs, ((0, 0), (W, Lp - L), (0, 0), (0, 0), (0, 0)))
    qb = qs.reshape(B, nb, ATTN_BLOCK, d, H, Dh)
    kidx = jnp.arange(nb)[:, None] * ATTN_BLOCK + jnp.arange(ATTN_BLOCK + W)[None, :]
    kb = ks[:, kidx]
    vb = vs[:, kidx]
    s = jnp.einsum('bnqrhd,bnkrhd->bnrhqk', qb, kb,
                   preferred_element_type=jnp.float32) * (Dh ** -0.5)
    rel = jnp.arange(ATTN_BLOCK)[:, None] + W - jnp.arange(ATTN_BLOCK + W)[None, :]
    key_j = kidx - W
    valid = ((rel >= 0) & (rel <= W))[None, :, :] & (key_j >= 0)[:, None, :]
    s = jnp.where(valid[None, :, None, None], s, NEG)
    m = jnp.max(s, axis=-1)
    p = jnp.exp(s - m[..., None])
    l = jnp.sum(p, axis=-1)
    o = jnp.einsum('bnrhqk,bnkrhd->bnqrhd', p.astype(v.dtype), vb,
                   preferred_element_type=jnp.float32)
    o = o / jnp.transpose(l, (0, 1, 4, 2, 3))[..., None]
    o = o.reshape(B, Lp, d, H, Dh)[:, :L].reshape(B, S, H, Dh)
    m = jnp.transpose(m, (0, 1, 4, 2, 3)).reshape(B, Lp, d, H)[:, :L].reshape(B, S, H)
    l = jnp.transpose(l, (0, 1, 4, 2, 3)).reshape(B, Lp, d, H)[:, :L].reshape(B, S, H)
    return o, m, l


def _merge_by_denominator(parts):
    m_all = functools_reduce_max([m for _, m, _ in parts])
    ws = [l * jnp.exp(m - m_all) for _, m, l in parts]
    num = sum(w[..., None] * o for (o, _, _), w in zip(parts, ws))
    return num / sum(ws)[..., None]


def functools_reduce_max(arrs):
    out = arrs[0]
    for a in arrs[1:]:
        out = jnp.maximum(out, a)
    return out


def _mla_attention(q_nope, q_pe, k_nope, k_pe, v):
    B, S, H, _ = q_nope.shape
    nb = S // ATTN_BLOCK
    scale = (QK_NOPE + QK_ROPE) ** -0.5
    qn = q_nope.reshape(B, nb, ATTN_BLOCK, H, QK_NOPE).transpose(1, 0, 2, 3, 4)
    qp = q_pe.reshape(B, nb, ATTN_BLOCK, H, QK_ROPE).transpose(1, 0, 2, 3, 4)
    kpos = jnp.arange(S)

    def block(args):
        i, qn_b, qp_b = args
        s = (jnp.einsum('bqhd,bkhd->bhqk', qn_b, k_nope, preferred_element_type=jnp.float32)
             + jnp.einsum('bqhd,bkd->bhqk', qp_b, k_pe, preferred_element_type=jnp.float32)) * scale
        qpos = i * ATTN_BLOCK + jnp.arange(ATTN_BLOCK)
        s = jnp.where(kpos[None, :] <= qpos[:, None], s, NEG)
        p = jax.nn.softmax(s, axis=-1)
        return jnp.einsum('bhqk,bkhd->bqhd', p.astype(v.dtype), v)

    o = lax.map(block, (jnp.arange(nb), qn, qp))
    return o.transpose(1, 0, 2, 3, 4).reshape(B, S, H, V_HEAD)


def _hybrid_mixer(x, w_in, g_q, w_uq, g_kv, w_ukv, g_out_dil, g_out_mla, w_o,
                  cos_d, sin_d, cos_m, sin_m):
    B, S, _ = x.shape
    proj = jnp.einsum('bsd,df->bsf', x, w_in)
    q_d, k_d, v_d, c_q, c_kv, k_pe = jnp.split(proj, IN_SPLITS, axis=-1)
    q_d = _partial_rope(q_d.reshape(B, S, N_HEADS_DIL, HEAD_DIM), cos_d, sin_d)
    k_d = _partial_rope(k_d.reshape(B, S, N_HEADS_DIL, HEAD_DIM), cos_d, sin_d)
    v_d = v_d.reshape(B, S, N_HEADS_DIL, HEAD_DIM)
    parts = [_dilated_window_attention(q_d, k_d, v_d, w, r) for (w, r) in DIL_PATTERNS]
    o_dil = _merge_by_denominator(parts).astype(x.dtype).reshape(B, S, DIL_WIDTH)
    c_q = _rmsnorm(c_q, g_q)
    q = jnp.einsum('bsr,rf->bsf', c_q, w_uq).reshape(B, S, N_HEADS_MLA, QK_NOPE + QK_ROPE)
    q_nope = q[..., :QK_NOPE]
    q_pe = _apply_rope(q[..., QK_NOPE:], cos_m, sin_m)
    c_kv = _rmsnorm(c_kv, g_kv)
    kv = jnp.einsum('bsr,rf->bsf', c_kv, w_ukv).reshape(B, S, N_HEADS_MLA, QK_NOPE + V_HEAD)
    k_nope, v_m = kv[..., :QK_NOPE], kv[..., QK_NOPE:]
    k_pe = _apply_rope(k_pe[:, :, None, :], cos_m, sin_m)[:, :, 0]
    o_mla = _mla_attention(q_nope, q_pe, k_nope, k_pe, v_m).reshape(B, S, MLA_WIDTH)
    y = jnp.concatenate([_rmsnorm(o_dil, g_out_dil), _rmsnorm(o_mla, g_out_mla)], axis=-1)
    return jnp.einsum('bsf,fd->bsd', y, w_o)


def _moe_ffn(x, router_w, router_bias, w1, w3, w2, ws1, ws3, ws2):
    B, S, D = x.shape
    T = B * S
    xf = x.reshape(T, D)
    logits = jnp.einsum('td,ed->te', xf, router_w, preferred_element_type=jnp.float32)
    scores = jax.nn.sigmoid(logits)
    choice = scores + router_bias.astype(jnp.float32)[None, :]
    grp = choice.reshape(T, N_GROUP, N_EXPERTS // N_GROUP)
    grp_score = jnp.sum(lax.top_k(grp, 2)[0], axis=-1)
    _, gidx = lax.top_k(grp_score, TOPK_GROUP)
    gmask = jnp.sum(jax.nn.one_hot(gidx, N_GROUP, dtype=jnp.float32), axis=1) > 0
    emask = jnp.repeat(gmask, N_EXPERTS // N_GROUP, axis=1)
    _, eidx = lax.top_k(jnp.where(emask, choice, -jnp.inf), TOP_K)
    gw = jnp.take_along_axis(scores, eidx, axis=1)
    gw = gw / jnp.sum(gw, axis=-1, keepdims=True) * ROUTED_SCALE
    TK = T * TOP_K
    flat_e = eidx.reshape(TK)
    flat_t = jnp.repeat(jnp.arange(T, dtype=jnp.int32), TOP_K)
    flat_w = gw.reshape(TK)
    order = jnp.argsort(flat_e, stable=True)
    se, st, sw = flat_e[order], flat_t[order], flat_w[order]
    counts = jnp.bincount(flat_e, length=N_EXPERTS)
    start = jnp.cumsum(counts) - counts
    padded = (counts + EXPERT_BLOCK - 1) // EXPERT_BLOCK * EXPERT_BLOCK
    pend = jnp.cumsum(padded)
    pstart = pend - padded
    dest = pstart[se] + (jnp.arange(TK, dtype=jnp.int32) - start[se])
    NB = -(-TK // EXPERT_BLOCK) + N_EXPERTS
    R = NB * EXPERT_BLOCK
    row_tok = jnp.full((R,), T, dtype=jnp.int32).at[dest].set(st)
    row_w = jnp.zeros((R,), jnp.float32).at[dest].set(sw)
    block_e = jnp.minimum(jnp.searchsorted(pend, jnp.arange(NB) * EXPERT_BLOCK, side='right'),
                          N_EXPERTS - 1)
    xpad = jnp.concatenate([xf, jnp.zeros((1, D), xf.dtype)], axis=0)

    def body(b, acc):
        tok = lax.dynamic_slice(row_tok, (b * EXPERT_BLOCK,), (EXPERT_BLOCK,))
        wb = lax.dynamic_slice(row_w, (b * EXPERT_BLOCK,), (EXPERT_BLOCK,))
        e = block_e[b]
        xb = xpad[tok]
        hb = jax.nn.silu(xb @ w1[e]) * (xb @ w3[e])
        yb = (hb @ w2[e]) * wb.astype(xb.dtype)[:, None]
        return acc.at[tok].add(yb.astype(acc.dtype))

    routed = lax.fori_loop(0, NB, body, jnp.zeros((T + 1, D), xf.dtype))[:T]
    shared = (jax.nn.silu(xf @ ws1) * (xf @ ws3)) @ ws2
    return (routed + shared).reshape(B, S, D)


def setup_inputs(seed: int = 0) -> dict:
    key = jax.random.key(seed)
    ks = jax.random.split(key, 24)
    L = DEPTH
    f32 = jnp.float32

    def nrm(k, shape, scale):
        return jax.random.normal(k, shape, f32) * scale

    def gain(k, shape):
        return 1.0 + 0.02 * jax.random.normal(k, shape, f32)

    return {
        "x": nrm(ks[0], (BATCH, SEQ, D_MODEL), 1.0),
        "w_in": nrm(ks[1], (L, D_MODEL, IN_WIDTH), D_MODEL ** -0.5),
        "g_q": gain(ks[2], (L, Q_LORA)),
        "w_uq": nrm(ks[3], (L, Q_LORA, N_HEADS_MLA * (QK_NOPE + QK_ROPE)), Q_LORA ** -0.5),
        "g_kv": gain(ks[4], (L, KV_LORA)),
        "w_ukv": nrm(ks[5], (L, KV_LORA, N_HEADS_MLA * (QK_NOPE + V_HEAD)), KV_LORA ** -0.5),
        "g_out_dil": gain(ks[6], (L, DIL_WIDTH)),
        "g_out_mla": gain(ks[7], (L, MLA_WIDTH)),
        "w_o": nrm(ks[8], (L, MIX_WIDTH, D_MODEL), MIX_WIDTH ** -0.5 * DEEPNORM_BETA),
        "ln1_g": gain(ks[9], (L, D_MODEL)),
        "ln1_b": nrm(ks[10], (L, D_MODEL), 0.02),
        "router_w": nrm(ks[11], (L, N_EXPERTS, D_MODEL), D_MODEL ** -0.5),
        "router_bias": nrm(ks[12], (L, N_EXPERTS), 0.01),
        "w1": nrm(ks[13], (L, N_EXPERTS, D_MODEL, EXPERT_FF), D_MODEL ** -0.5),
        "w3": nrm(ks[14], (L, N_EXPERTS, D_MODEL, EXPERT_FF), D_MODEL ** -0.5),
        "w2": nrm(ks[15], (L, N_EXPERTS, EXPERT_FF, D_MODEL), EXPERT_FF ** -0.5 * DEEPNORM_BETA),
        "ws1": nrm(ks[16], (L, D_MODEL, SHARED_FF), D_MODEL ** -0.5),
        "ws3": nrm(ks[17], (L, D_MODEL, SHARED_FF), D_MODEL ** -0.5),
        "ws2": nrm(ks[18], (L, SHARED_FF, D_MODEL), SHARED_FF ** -0.5 * DEEPNORM_BETA),
        "ln2_g": gain(ks[19], (L, D_MODEL)),
        "ln2_b": nrm(ks[20], (L, D_MODEL), 0.02),
    }


def reference(x, w_in, g_q, w_uq, g_kv, w_ukv, g_out_dil, g_out_mla, w_o, ln1_g, ln1_b,
              router_w, router_bias, w1, w3, w2, ws1, ws3, ws2, ln2_g, ln2_b):
    S = x.shape[1]
    cos_d, sin_d = _rope_table(S, ROPE_DIM_DIL)
    cos_m, sin_m = _rope_table(S, QK_ROPE)
    h = x
    for layer in range(DEPTH):
        mix = _hybrid_mixer(h, w_in[layer], g_q[layer], w_uq[layer], g_kv[layer], w_ukv[layer],
                            g_out_dil[layer], g_out_mla[layer], w_o[layer],
                            cos_d, sin_d, cos_m, sin_m)
        h = _layernorm(DEEPNORM_ALPHA * h + mix, ln1_g[layer], ln1_b[layer])
        ffn = _moe_ffn(h, router_w[layer], router_bias[layer], w1[layer], w3[layer], w2[layer],
                       ws1[layer], ws3[layer], ws2[layer])
        h = _layernorm(DEEPNORM_ALPHA * h + ffn, ln2_g[layer], ln2_b[layer])
    return h
```

```cpp
#include <hip/hip_runtime.h>
#include <stdint.h>
#include <stdio.h>

#define DI __device__ __forceinline__
#ifndef REP_P0
#define REP_P0 1
#endif
#ifndef REP_P1
#define REP_P1 1
#endif
#ifndef REP_P2
#define REP_P2 1
#ifndef REP_P2B
#define REP_P2B 1
#endif
#endif
#ifndef REP_MLA
#define REP_MLA 1
#endif
#ifndef REP_DIL
#define REP_DIL 1
#endif
#ifndef REP_P4
#define REP_P4 1
#endif
#ifndef REP_P7
#define REP_P7 1
#endif
#ifndef REP_P8
#define REP_P8 1
#endif
#define LAS __attribute__((address_space(3)))
typedef unsigned short bf16;
typedef short bf16x8 __attribute__((ext_vector_type(8)));
typedef short s16x4 __attribute__((ext_vector_type(4)));
typedef int i32x4 __attribute__((ext_vector_type(4)));
typedef float f32x16 __attribute__((ext_vector_type(16)));
typedef float f32x4 __attribute__((ext_vector_type(4)));
typedef float f32x2 __attribute__((ext_vector_type(2)));
typedef unsigned u32x4 __attribute__((ext_vector_type(4)));
typedef unsigned u32x2 __attribute__((ext_vector_type(2)));
typedef __bf16 bf16x2_t __attribute__((ext_vector_type(2)));

constexpr int T = 65536, DM = 1024, SEQ = 4096, NBATCH = 16;
constexpr int NE = 256, TOPK = 8, FF = 256;
constexpr int INW = 2080;
constexpr float ALPHA = 1.189207115002721f;
constexpr float LN_EPS = 1e-5f, RMS_EPS = 1e-6f;
constexpr float LOG2E = 1.4426950408889634f;
constexpr float CD2 = 0.125f * LOG2E;
constexpr float CM2 = 0.10206207261596575f * LOG2E;
constexpr float NEG = -1e30f;

constexpr size_t MiB = 1u << 20;
constexpr size_t WS_CTL = 0, CTL_BYTES = 1 * MiB;
constexpr size_t WS_ROPE_D = 1 * MiB;
constexpr size_t WS_ROPE_M = 1 * MiB + 256 * 1024;
constexpr size_t WS_W_IN_T = 2 * MiB;
constexpr size_t WS_W_UQ_T = 7 * MiB;
constexpr size_t WS_W_UKV_T = 8 * MiB;
constexpr size_t WS_W_O_T = 9 * MiB;
constexpr size_t WS_W_R = 11 * MiB;
constexpr size_t WS_WS13_T = 12 * MiB;
constexpr size_t WS_WS2_T = 13 * MiB;
constexpr size_t WS_W2_T = 16 * MiB;
constexpr size_t WS_W13_T = 144 * MiB;
constexpr size_t WS_XB = 400 * MiB;
constexpr size_t WS_Y = 400 * MiB;
constexpr size_t WS_QD = 528 * MiB, WS_KD = 592 * MiB, WS_VD = 656 * MiB;
constexpr size_t WS_CQKV = 720 * MiB;
constexpr size_t WS_KPE = 784 * MiB;
constexpr size_t WS_QM = 788 * MiB;
constexpr size_t WS_KVM = 884 * MiB;
constexpr size_t WS_SSQC = 1012 * MiB;
constexpr size_t WS_SSQO = 1016 * MiB;
constexpr size_t WS_MIXB = 528 * MiB;
constexpr int H1_LD = 2048;
constexpr size_t WS_Y2C = 144 * MiB;
constexpr size_t WS_LOGITS = 656 * MiB;
constexpr size_t WS_HB = 656 * MiB;
constexpr size_t WS_HS = 944 * MiB;
constexpr size_t WS_ROWINFO = 976 * MiB;
constexpr size_t WS_EIDX = 982 * MiB, WS_GWT = 984 * MiB, WS_RANK = 986 * MiB;
constexpr size_t WS_END = 988 * MiB;
constexpr size_t WS_RQRK = 1020 * MiB;
constexpr size_t WS_RDRM = 1021 * MiB;
constexpr size_t WS_NEED = 1022 * MiB;
constexpr int RMAX = T * TOPK + NE * 255;
constexpr size_t DO_ODP = 0, DO_MLP = 192 * MiB;
constexpr int CW_BAR = 4096;
constexpr int CW_TOTAL = 16384;

constexpr int LDS_WSCR = 0;
constexpr int LDS_TAB = 147456 - 64 - 3072;
constexpr int LDS_MISC = 147456 - 64;
constexpr int LDS_BYTES = 147456;

#define XB_TMO      128
#define XB_XCNT(j)  (256  + 64 * (j))
#define XB_XSUB(j)  (1280 + 64 * (j))
#define XB_XGEN(j)  (2304 + 64 * (j))
#define XB_TOP      3328
#define XB_TOPGEN   3392
#define XCD_BAR_WORDS 3456
#define XB_SPIN_CAP (1u << 22)

__device__ __forceinline__ unsigned xb_ld(unsigned* p)              { return __hip_atomic_load(p, __ATOMIC_RELAXED, __HIP_MEMORY_SCOPE_AGENT); }
__device__ __forceinline__ unsigned xb_add(unsigned* p, unsigned v) { return __hip_atomic_fetch_add(p, v, __ATOMIC_RELAXED, __HIP_MEMORY_SCOPE_AGENT); }
__device__ __forceinline__ unsigned xb_xcc_id() { return (unsigned)__builtin_amdgcn_s_getreg((3 << 11) | 20) & 0xFu; }
#define XB_SPIN(cond, bar) do { unsigned _sp = 0; while (cond) { __builtin_amdgcn_s_sleep(1); \
    if ((++_sp & 255u) == 0u) { if (xb_ld(&(bar)[XB_TMO])) break; if (_sp > XB_SPIN_CAP) { atomicAdd(&(bar)[XB_TMO], 1u); break; } } } } while (0)

struct XcdBarrier { unsigned* bar; unsigned x; volatile LAS unsigned* st; };

__device__ __forceinline__ XcdBarrier xcd_barrier_post(unsigned* bar, volatile LAS unsigned* st) {
    XcdBarrier b; b.bar = bar; b.x = xb_xcc_id(); b.st = st;
    if (threadIdx.x == 0) (void)xb_add(&bar[XB_XCNT(b.x)], 1u);
    return b;
}
__device__ __forceinline__ void xcd_barrier_complete(unsigned* bar, unsigned x, unsigned& nloc, unsigned& nx) {
    const unsigned G = gridDim.x * gridDim.y * gridDim.z;
    unsigned sum, cnt, mine, sp = 0u;
    for (;;) {
        sum = 0u; cnt = 0u; mine = 0u;
#pragma unroll
        for (unsigned j = 0; j < 16; ++j) { const unsigned c = xb_ld(&bar[XB_XCNT(j)]); sum += c; cnt += (c > 0u) ? 1u : 0u; mine = (j == x) ? c : mine; }
        if (sum == G) break;
        __builtin_amdgcn_s_sleep(1);
        if ((++sp & 255u) == 0u) { if (xb_ld(&bar[XB_TMO])) break; if (sp > XB_SPIN_CAP) { atomicAdd(&bar[XB_TMO], 1u); break; } }
    }
    nloc = mine > 0u ? mine : 1u; nx = cnt > 0u ? cnt : 1u;
}
__device__ __forceinline__ void xcd_barrier(const XcdBarrier& b) {
    asm volatile("s_waitcnt vmcnt(0)" ::: "memory");
    __syncthreads();
    if (threadIdx.x == 0) {
        unsigned* bar = b.bar;
        __builtin_amdgcn_s_waitcnt(0);
        unsigned nloc = b.st[0], nx = b.st[1];
        if (nloc == 0u) { xcd_barrier_complete(bar, b.x, nloc, nx); b.st[0] = nloc; b.st[1] = nx; }
        const unsigned old = xb_add(&bar[XB_XSUB(b.x)], 1u);
        const unsigned gen = old / nloc;
        if (old + 1u == (gen + 1u) * nloc) {
            __builtin_amdgcn_fence(__ATOMIC_RELEASE, "agent");
            asm volatile("s_waitcnt vmcnt(0)" ::: "memory");
            const unsigned og = xb_add(&bar[XB_TOP], 1u);
            const unsigned tg = og / nx;
            if (og + 1u == (tg + 1u) * nx) xb_add(&bar[XB_TOPGEN], 1u);
            else XB_SPIN(xb_ld(&bar[XB_TOPGEN]) == tg, bar);
            __builtin_amdgcn_fence(__ATOMIC_ACQUIRE, "agent");
            xb_add(&bar[XB_XGEN(b.x)], 1u);
            asm volatile("s_waitcnt vmcnt(0)" ::: "memory");
        } else {
            XB_SPIN(xb_ld(&bar[XB_XGEN(b.x)]) == gen, bar);
            __builtin_amdgcn_fence(__ATOMIC_ACQUIRE, "agent");
            asm volatile("s_waitcnt vmcnt(0)" ::: "memory");
        }
    }
    __syncthreads();
}

DI int crow(int r, int h) { return (r & 3) + 8 * (r >> 2) + 4 * h; }
DI unsigned pk2(float lo, float hi) { f32x2 v = {lo, hi}; bf16x2_t b = __builtin_convertvector(v, bf16x2_t); return __builtin_bit_cast(unsigned, b); }
DI float bf2f(bf16 v) { return __builtin_bit_cast(float, (unsigned)v << 16); }
DI float wave_sum(float v) {
#pragma unroll
    for (int o = 1; o < 64; o <<= 1) v += __shfl_xor(v, o);
    return v;
}
#define MFMA32(a, b, c) __builtin_amdgcn_mfma_f32_32x32x16_bf16((a), (b), (c), 0, 0, 0)
DI s16x4 tr_read(const LAS unsigned char* p) { return __builtin_bit_cast(s16x4, __builtin_amdgcn_ds_read_tr16_b64_v4i16((LAS s16x4*)p)); }

DI void store_tile_bf16(bf16* dst, const f32x16& v, int h) {
    unsigned d[4][2];
#pragma unroll
    for (int g = 0; g < 4; ++g) { d[g][0] = pk2(v[4 * g], v[4 * g + 1]); d[g][1] = pk2(v[4 * g + 2], v[4 * g + 3]); }
#pragma unroll
    for (int pc = 0; pc < 2; ++pc) {
        const auto s0 = __builtin_amdgcn_permlane32_swap(d[2 * pc][0], d[2 * pc + 1][0], false, false);
        const auto s1 = __builtin_amdgcn_permlane32_swap(d[2 * pc][1], d[2 * pc + 1][1], false, false);
        u32x4 o; o[0] = s0[0]; o[1] = s1[0]; o[2] = s0[1]; o[3] = s1[1];
        *(u32x4*)(dst + 16 * pc + 8 * h) = o;
    }
}

template <int I> DI const float* in_ptr() {
    const float* p; const void* ka = (const void*)__builtin_amdgcn_kernarg_segment_ptr();
    asm volatile("s_load_dwordx2 %0, %1, %2\n\ts_waitcnt lgkmcnt(0)" : "=s"(p) : "s"(ka), "i"(I * 8) : "memory");
    return p;
}
enum { IN_X = 0, IN_W_IN, IN_G_Q, IN_W_UQ, IN_G_KV, IN_W_UKV, IN_G_OD, IN_G_OM, IN_W_O, IN_LN1G, IN_LN1B, IN_ROUTER_W, IN_ROUTER_B, IN_W1, IN_W3, IN_W2, IN_WS1, IN_WS3, IN_WS2, IN_LN2G, IN_LN2B };

struct Frame {
    float* out; unsigned char* ws;
    int wave, gw, ngw;
    LAS unsigned char* lds;
};

DI void transpose_item(const float* W, int ldn, int k0, int n0, bf16* dst, int Kd, const float* g, LAS float* scr, int lane) {
#pragma unroll 8
    for (int i = 0; i < 32; ++i) { const int kk = 2 * i + (lane >> 5); float v = W[(size_t)(k0 + kk) * ldn + n0 + (lane & 31)]; if (g) v *= g[k0 + kk]; scr[kk * 33 + (lane & 31)] = v; }
    asm volatile("s_waitcnt lgkmcnt(0)" ::: "memory");
    const int c = lane & 7;
#pragma unroll
    for (int j = 0; j < 4; ++j) { const int n = (lane >> 3) + 8 * j; const LAS float* s = scr + (8 * c) * 33 + n;
        u32x4 o; o.x = pk2(s[0 * 33], s[1 * 33]); o.y = pk2(s[2 * 33], s[3 * 33]); o.z = pk2(s[4 * 33], s[5 * 33]); o.w = pk2(s[6 * 33], s[7 * 33]);
        *(u32x4*)(dst + (size_t)n * Kd + k0 + 8 * c) = o; }
    asm volatile("s_waitcnt lgkmcnt(0)" ::: "memory");
}
DI void transpose_plain(const float* W, int K, int N, bf16* WT, const float* g, int item, LAS float* scr, int lane) {
    const int nblk = N / 32, kb = item / nblk, nb = item % nblk;
    transpose_item(W, N, 64 * kb, 32 * nb, WT + (size_t)(32 * nb) * K, K, g, scr, lane);
}
DI void transpose_gate(const float* W, int s, bf16* WT13, int item, LAS float* scr, int lane) {
    const int kb = item / 8, nb = item % 8, n0 = 32 * nb;
    const int drow = 256 * (n0 >> 7) + 128 * s + (n0 & 127);
    transpose_item(W, 256, 64 * kb, n0, WT13 + (size_t)drow * 1024, 1024, nullptr, scr, lane);
}

DI void transpose_tile64(const float* W, int ldn, int k0, int n0, bf16* dst, int Kd, LAS float* scr, int lane) {
    f32x4 v[16];
    const float* src = W + (size_t)(k0 + (lane >> 4)) * ldn + n0 + 4 * (lane & 15);
#pragma unroll
    for (int i = 0; i < 16; ++i) v[i] = *(const f32x4*)(src + (size_t)(4 * i) * ldn);
#pragma unroll
    for (int i = 0; i < 16; ++i) *(LAS f32x4*)(scr + (4 * i + (lane >> 4)) * 68 + 4 * (lane & 15)) = v[i];
    asm volatile("s_waitcnt lgkmcnt(0)" ::: "memory");
#pragma unroll
    for (int kc = 0; kc < 8; ++kc) { const LAS float* p = scr + (8 * kc) * 68 + lane;
        u32x4 o; o.x = pk2(p[0], p[68]); o.y = pk2(p[2 * 68], p[3 * 68]); o.z = pk2(p[4 * 68], p[5 * 68]); o.w = pk2(p[6 * 68], p[7 * 68]);
        *(u32x4*)(dst + (size_t)lane * Kd + k0 + 8 * kc) = o; }
    asm volatile("s_waitcnt lgkmcnt(0)" ::: "memory");
}
DI void transpose_expert_tile(const float* W, int m, bf16* WT13, bf16* WT2, int q, LAS float* scr, int lane) {
    if (m < 2) { const int kb = q >> 2, nb = q & 3, n0 = 64 * nb; const int drow = 256 * (n0 >> 7) + 128 * m + (n0 & 127);
        transpose_tile64(W, 256, 64 * kb, n0, WT13 + (size_t)drow * 1024, 1024, scr, lane); }
    else { const int kb = q >> 4, nb = q & 15; transpose_tile64(W, 1024, 64 * kb, 64 * nb, WT2 + (size_t)(64 * nb) * 256, 256, scr, lane); }
}

DI void p0_prologue(Frame& F) {
    const float *Fx = in_ptr<IN_X>(), *Fw_in = in_ptr<IN_W_IN>(), *Fg_q = in_ptr<IN_G_Q>(), *Fw_uq = in_ptr<IN_W_UQ>(), *Fg_kv = in_ptr<IN_G_KV>(), *Fw_ukv = in_ptr<IN_W_UKV>(), *Fg_od = in_ptr<IN_G_OD>(), *Fg_om = in_ptr<IN_G_OM>(), *Fw_o = in_ptr<IN_W_O>(), *Frouter_w = in_ptr<IN_ROUTER_W>();
    LAS float* scr = (LAS float*)(F.lds + LDS_WSCR + F.wave * 17408);
    unsigned char* ws = F.ws;
    constexpr int I_IN = 16 * 65, I_UQ = 6 * 24, I_UKV = 2 * 32, I_O = 16 * 32;
    constexpr int I_SMALL = I_IN + I_UQ + I_UKV + I_O;
    for (int it = F.gw; it < I_SMALL; it += F.ngw) {
        int r = it;
        if (r < I_IN) { transpose_plain(Fw_in, 1024, INW, (bf16*)(ws + WS_W_IN_T), nullptr, r, scr, ((int)threadIdx.x & 63)); continue; } r -= I_IN;
        if (r < I_UQ) { transpose_plain(Fw_uq, 384, 768, (bf16*)(ws + WS_W_UQ_T), Fg_q, r, scr, ((int)threadIdx.x & 63)); continue; } r -= I_UQ;
        if (r < I_UKV) { const int kb = r / 32, nb = r % 32;
            transpose_item(Fw_ukv, 1024, 64 * kb, 32 * nb, (bf16*)(ws + WS_W_UKV_T) + (size_t)(32 * nb) * 256 + 128, 256, Fg_kv, scr, ((int)threadIdx.x & 63)); continue; } r -= I_UKV;
        {
            const int kb = r / 32, nb = r % 32; const float* g = (kb < 8) ? Fg_od : (Fg_om - 512);
            transpose_item(Fw_o, 1024, 64 * kb, 32 * nb, (bf16*)(ws + WS_W_O_T) + (size_t)(32 * nb) * 1024, 1024, g, scr, ((int)threadIdx.x & 63)); }
    }
    const int gt = blockIdx.x * 512 + ((int)threadIdx.x), ngt = gridDim.x * 512;
    for (int i = gt; i < (2304 - INW) * 1024 / 8; i += ngt) *(u32x4*)((bf16*)(ws + WS_W_IN_T) + (size_t)INW * 1024 + (size_t)i * 8) = (u32x4){0u, 0u, 0u, 0u};
    for (int i = gt; i < 1024 * 128 / 8; i += ngt) { const int n = i >> 4, c8 = i & 15; *(u32x4*)((bf16*)(ws + WS_W_UKV_T) + (size_t)n * 256 + c8 * 8) = (u32x4){0u, 0u, 0u, 0u}; }
    for (int i = gt; i < NE * 1024 / 8; i += ngt) { const f32x4 a = *(const f32x4*)(Frouter_w + (size_t)i * 8), b = *(const f32x4*)(Frouter_w + (size_t)i * 8 + 4);
        u32x4 o; o.x = pk2(a.x, a.y); o.y = pk2(a.z, a.w); o.z = pk2(b.x, b.y); o.w = pk2(b.z, b.w); *(u32x4*)((bf16*)(ws + WS_W_R) + (size_t)i * 8) = o; }
#pragma unroll 4
    for (int i = gt; i < T * 1024 / 8; i += ngt) { const f32x4 a = *(const f32x4*)(Fx + (size_t)i * 8), b = *(const f32x4*)(Fx + (size_t)i * 8 + 4);
        u32x4 o; o.x = pk2(a.x, a.y); o.y = pk2(a.z, a.w); o.z = pk2(b.x, b.y); o.w = pk2(b.z, b.w); *(u32x4*)((bf16*)(ws + WS_XB) + (size_t)i * 8) = o; }
    for (int i = gt; i < SEQ * 24; i += ngt) {
        const int pos = i / 24, j = i % 24;
        float inv; float* dst;
        if (j < 8) { inv = powf(500000.0f, -(float)(2 * j) / 16.0f); dst = (float*)(ws + WS_ROPE_D) + (size_t)(pos * 8 + j) * 2; }
        else { const int jj = j - 8; inv = powf(500000.0f, -(float)(2 * jj) / 32.0f); dst = (float*)(ws + WS_ROPE_M) + (size_t)(pos * 16 + jj) * 2; }
        const float ang = (float)pos * inv; float sn, cs; sincosf(ang, &sn, &cs);
        dst[0] = cs; dst[1] = sn;
    }
}

namespace pg {
typedef float f32x4 __attribute__((ext_vector_type(4)));
constexpr int BM = 256, BK = 64, HALF = 128, HTB = HALF * BK * 2, STAGE_BYTES = 8 * HTB, NXCD = 8, WGM = 8;
__host__ __device__ __forceinline__ int lds_byte(int r, int c) { const int st = (r >> 4) * 2 + (c >> 5), rr = r & 15, cc = c & 31, ob = rr * 64 + cc * 2; return st * 1024 + (ob ^ (((ob >> 9) & 1) << 5)); }
__host__ __device__ __forceinline__ void stage_rc(int b, int& R, int& C) { const int st = b / 1024, sb = b % 1024, swz = sb ^ (((sb >> 9) & 1) << 5); R = (st >> 1) * 16 + swz / 64; C = (st & 1) * 32 + (swz % 64) / 2; }
__host__ __device__ __forceinline__ int perm32(int rho) { const int n = rho >> 4, i = rho & 15; return 8 * (i >> 2) + 4 * n + (i & 3); }

struct Unit { int pm, pn; const char* B; int kind, rb; };

DI int xcd_deal(int i, int G, int c, int nwg) {
    const long L = (long)i * G + c; if (L >= nwg) return -1;
    int wgid = (int)L; const int q = nwg / NXCD, r = nwg % NXCD, xcd = wgid % NXCD, off = wgid / NXCD;
    return (xcd < r ? xcd * (q + 1) : r * (q + 1) + (xcd - r) * q) + off;
}

template <class Epi, class Sched>
DI void gemm_phase(LAS unsigned char* lds, const char* Abase, int lda, int K, const Sched& S, const Epi& E) {
    int tid = threadIdx.x; asm volatile("" : "+v"(tid));
    const int wid = __builtin_amdgcn_readfirstlane(tid >> 6), lane = tid & 63, wr = wid >> 2, wc = wid & 3, fr = lane & 15, fq = lane >> 4;
    asm volatile("" : "+s"(K), "+s"(lda));
    const int nt = K / BK;
    unsigned voffA[2], voffB[2];
#pragma unroll
    for (int i = 0; i < 2; ++i) { int R, C; stage_rc(tid * 16 + i * 8192, R, C); const int Rb = Epi::PERM ? ((R & ~31) + perm32(R & 31)) : R; voffA[i] = (unsigned)(R * lda + C) * 2u; voffB[i] = (unsigned)(Rb * K + C) * 2u; }
    const size_t hstepA = (size_t)HALF * lda * 2;
    const size_t kstep = (size_t)(BK * 2);
    const size_t hstepB = (size_t)HALF * K * 2;
    const unsigned ldsw = (unsigned)wid * 1024u;
    const int aoff = lds_byte(wr * 64 + fr, fq * 8), boff = lds_byte(wc * 32 + fr, fq * 8);
#define PG_SA(b, h) (((b) * 2 + (h)) * HTB)
#define PG_SB(b, h) ((4 + (b) * 2 + (h)) * HTB)
#define PG_STAGE_A(bufoff, half, kb, nx) do { \
        if constexpr (Sched::GATHER) { const unsigned _o0 = (nx) ? ((half) ? na1[0] : na0[0]) : ((half) ? ca1[0] : ca0[0]), _o1 = (nx) ? ((half) ? na1[1] : na0[1]) : ((half) ? ca1[1] : ca0[1]); \
            __builtin_amdgcn_global_load_lds((const unsigned*)(Abase + (kb) + _o0), (LAS unsigned*)(lds + (bufoff) + ldsw), 16, 0, 0); \
            __builtin_amdgcn_global_load_lds((const unsigned*)(Abase + (kb) + _o1), (LAS unsigned*)(lds + (bufoff) + ldsw + 8192), 16, 0, 0); } \
        else { const char* _b = ((nx) ? nA : cA) + (kb) + ((half) ? hstepA : (size_t)0); _Pragma("unroll") for (int _i = 0; _i < 2; ++_i) \
            __builtin_amdgcn_global_load_lds((const unsigned*)(_b + voffA[_i]), (LAS unsigned*)(lds + (bufoff) + ldsw + _i * 8192), 16, 0, 0); } } while (0)
#define PG_STAGE_B(bufoff, gbase) do { _Pragma("unroll") for (int _i = 0; _i < 2; ++_i) \
        __builtin_amdgcn_global_load_lds((const unsigned*)((const char*)(gbase) + voffB[_i]), (LAS unsigned*)(lds + (bufoff) + ldsw + _i * 8192), 16, 0, 0); } while (0)
#define PG_LDA(dst, b, h) do { _Pragma("unroll") for (int m = 0; m < 4; ++m) _Pragma("unroll") for (int k = 0; k < 2; ++k) dst[m][k] = *(const LAS bf16x8*)(lds + PG_SA(b, h) + aoff + m * 2048 + k * 1024); } while (0)
#define PG_LDB(dst, b, h) do { _Pragma("unroll") for (int n = 0; n < 2; ++n) _Pragma("unroll") for (int k = 0; k < 2; ++k) dst[n][k] = *(const LAS bf16x8*)(lds + PG_SB(b, h) + boff + n * 2048 + k * 1024); } while (0)
#define PG_MMA(ai, bj, At, Bt) do { __builtin_amdgcn_s_setprio(1); _Pragma("unroll") for (int m = 0; m < 4; ++m) _Pragma("unroll") for (int n = 0; n < 2; ++n) _Pragma("unroll") for (int k = 0; k < 2; ++k) \
        acc[ai][bj][m][n] = __builtin_amdgcn_mfma_f32_16x16x32_bf16(Bt[n][k], At[m][k], acc[ai][bj][m][n], 0, 0, 0); __builtin_amdgcn_s_setprio(0); } while (0)
#define PG_WAIT_V(n) asm volatile("s_waitcnt vmcnt(" #n ")" ::: "memory")
#define PG_WAIT_L(n) asm volatile("s_waitcnt lgkmcnt(" #n ")" ::: "memory")
#define PG_BAR __builtin_amdgcn_s_barrier()
#define PG_SCHED __builtin_amdgcn_sched_barrier(0)
    Unit cur, nxt; int ui = 0;
    if (!S.next(0, cur)) return;
    f32x4 acc[2][2][4][2];
#pragma unroll
    for (int a = 0; a < 2; ++a)
#pragma unroll
        for (int b = 0; b < 2; ++b)
#pragma unroll
            for (int m = 0; m < 4; ++m)
#pragma unroll
                for (int n = 0; n < 2; ++n) acc[a][b][m][n] = (f32x4){0.f, 0.f, 0.f, 0.f};
    bf16x8 At[4][2], B0[2][2], B1[2][2];
    unsigned ca0[2] = {0u, 0u}, ca1[2] = {0u, 0u}, na0[2] = {0u, 0u}, na1[2] = {0u, 0u};
    const char* cA = Abase; const char* nA = Abase;
    if constexpr (Sched::GATHER) {
#pragma unroll
        for (int i = 0; i < 2; ++i) { int R, C; stage_rc(tid * 16 + i * 8192, R, C); ca0[i] = (unsigned)(S.arow(cur, R) * lda + C) * 2u; ca1[i] = (unsigned)(S.arow(cur, HALF + R) * lda + C) * 2u; na0[i] = ca0[i]; na1[i] = ca1[i]; }
    } else { cA = Abase + (size_t)S.arow(cur, 0) * lda * 2; nA = cA; }
    const char* cB = cur.B;
    PG_STAGE_B(PG_SB(0, 0), cB); PG_STAGE_B(PG_SB(0, 1), cB + hstepB); PG_STAGE_A(PG_SA(0, 0), 0, (size_t)0, false); PG_STAGE_A(PG_SA(0, 1), 1, (size_t)0, false);
    if (wr == 1) PG_BAR;
    PG_WAIT_V(2); PG_BAR;
    PG_STAGE_B(PG_SB(1, 0), cB + kstep); PG_STAGE_A(PG_SA(1, 0), 0, kstep, false); PG_STAGE_B(PG_SB(1, 1), cB + hstepB + kstep);
    PG_WAIT_V(6); PG_BAR;
    for (;;) {
        const bool has_next = S.next(ui + 1, nxt);
        if (has_next) {
            if constexpr (Sched::GATHER) {
#pragma unroll
                for (int i = 0; i < 2; ++i) { int R, C; stage_rc(tid * 16 + i * 8192, R, C); na0[i] = (unsigned)(S.arow(nxt, R) * lda + C) * 2u; na1[i] = (unsigned)(S.arow(nxt, HALF + R) * lda + C) * 2u; }
            } else nA = Abase + (size_t)S.arow(nxt, 0) * lda * 2;
        }
        const char* nB = has_next ? nxt.B : cB;
        for (int t = 0; t < nt; t += 2) {
            const bool last = (t == nt - 2);
            const size_t kb1 = (size_t)(t + 1) * kstep;
            const size_t kb2 = last ? 0 : (size_t)(t + 2) * kstep, kb3 = kb2 + kstep;
            const char* b2 = last ? nB : cB + (size_t)(t + 2) * kstep; const char* b3 = b2 + kstep;
            if constexpr (Epi::MIDK >= 0) { if (t == Epi::MIDK) E.midk(acc, cur, wr, wc, fr, fq); }
            PG_LDB(B0, 0, 0); PG_LDB(B1, 0, 1); PG_SCHED; PG_LDA(At, 0, 0); PG_STAGE_A(PG_SA(1, 1), 1, kb1, false);
            PG_WAIT_V(8); PG_WAIT_L(0); PG_BAR; PG_MMA(0, 0, At, B0); PG_MMA(0, 1, At, B1); PG_BAR; PG_SCHED;
            PG_LDA(At, 0, 1); PG_STAGE_B(PG_SB(0, 0), b2); PG_STAGE_B(PG_SB(0, 1), b2 + hstepB); PG_STAGE_A(PG_SA(0, 0), 0, kb2, last);
            PG_WAIT_V(8); PG_WAIT_L(0); PG_BAR; PG_MMA(1, 0, At, B0); PG_MMA(1, 1, At, B1); PG_BAR; PG_SCHED;
            PG_LDB(B0, 1, 0); PG_LDB(B1, 1, 1); PG_SCHED; PG_LDA(At, 1, 0); PG_STAGE_A(PG_SA(0, 1), 1, kb2, last);
            PG_WAIT_V(8); PG_WAIT_L(0); PG_BAR; PG_MMA(0, 0, At, B0); PG_MMA(0, 1, At, B1); PG_BAR; PG_SCHED;
            PG_LDA(At, 1, 1); PG_STAGE_B(PG_SB(1, 0), b3); PG_STAGE_B(PG_SB(1, 1), b3 + hstepB); PG_STAGE_A(PG_SA(1, 0), 0, kb3, last);
            PG_WAIT_V(8); PG_WAIT_L(0); PG_BAR; PG_MMA(1, 0, At, B0); PG_MMA(1, 1, At, B1); PG_BAR; PG_SCHED;
        }
        if (wr == 0) PG_BAR;
        E(acc, cur, wr, wc, fr, fq);
        if (!has_next) break;
#pragma unroll
        for (int a = 0; a < 2; ++a)
#pragma unroll
            for (int b = 0; b < 2; ++b)
#pragma unroll
                for (int m = 0; m < 4; ++m)
#pragma unroll
                    for (int n = 0; n < 2; ++n) acc[a][b][m][n] = (f32x4){0.f, 0.f, 0.f, 0.f};
        cur = nxt; cB = nB; cA = nA; ++ui;
        if constexpr (Sched::GATHER) {
#pragma unroll
            for (int i = 0; i < 2; ++i) { ca0[i] = na0[i]; ca1[i] = na1[i]; }
        }
        if (wr == 1) PG_BAR;
    }
    PG_WAIT_V(0);
    PG_BAR;
#undef PG_SA
#undef PG_SB
#undef PG_STAGE_A
#undef PG_STAGE_B
#undef PG_LDA
#undef PG_LDB
#undef PG_MMA
#undef PG_WAIT_V
#undef PG_WAIT_L
#undef PG_BAR
#undef PG_SCHED
}
}

DI float sigmoidf_(float x) { return 1.0f / (1.0f + __expf(-x)); }
#define TOP8_INSERT(cv_, ce_) do { float cv = (cv_); int ce = (ce_); _Pragma("unroll") for (int k_ = 0; k_ < 8; ++k_) { const bool sw = cv > tv[k_] || (cv == tv[k_] && ce < ti[k_]); \
        const float t1 = sw ? tv[k_] : cv; const int i1 = sw ? ti[k_] : ce; tv[k_] = sw ? cv : tv[k_]; ti[k_] = sw ? ce : ti[k_]; cv = t1; ce = i1; } } while (0)
DI void p5c_route(Frame& F, const int tb0 = -1, const int tend_ = 0, const int tstep_ = 0) {
    unsigned char* ws = F.ws;
    const float* LG = (const float*)(ws + WS_LOGITS); const float* rbias = in_ptr<IN_ROUTER_B>();
    int* EIDX = (int*)(ws + WS_EIDX); float* GWT = (float*)(ws + WS_GWT); int* RANK = (int*)(ws + WS_RANK);
    unsigned* total = (unsigned*)(ws + WS_CTL) + CW_TOTAL;
    LAS float* CH = (LAS float*)(F.lds);
    LAS float* GS = (LAS float*)(F.lds + 128 * 257 * 4);
    const int tid = (int)threadIdx.x;
    const int tbA = tb0 < 0 ? (int)blockIdx.x * 128 : tb0, tbE = tb0 < 0 ? T : tend_, tbS = tb0 < 0 ? (int)gridDim.x * 128 : tstep_;
    for (int tb = tbA; tb < tbE; tb += tbS) {
        __syncthreads();
#pragma unroll 4
        for (int i = 0; i < 16; ++i) { const int c4 = tid + 512 * i, tok = c4 >> 6, e0 = (c4 & 63) * 4;
            const f32x4 x = *(const f32x4*)(LG + (size_t)(tb + tok) * 256 + e0), bb = *(const f32x4*)(rbias + e0);
            LAS float* d = CH + tok * 257 + e0;
            d[0] = sigmoidf_(x.x) + bb.x; d[1] = sigmoidf_(x.y) + bb.y; d[2] = sigmoidf_(x.z) + bb.z; d[3] = sigmoidf_(x.w) + bb.w; }
        __syncthreads();
        const int tok = tid >> 2, j = tid & 3;
        const LAS float* row = CH + tok * 257;
        {
#pragma unroll
            for (int gg = 0; gg < 2; ++gg) { float a = -INFINITY, b = -INFINITY; const LAS float* p = row + 64 * j + 32 * gg;
                for (int i = 0; i < 32; ++i) { const float c = p[i]; if (c > a) { b = a; a = c; } else if (c > b) b = c; }
                GS[tok * 8 + 2 * j + gg] = a + b; }
        }
        __syncthreads();
        float gs[8];
#pragma unroll
        for (int g = 0; g < 8; ++g) gs[g] = GS[tok * 8 + g];
        int mygrp = 0, nsel = 0;
#pragma unroll
        for (int g = 0; g < 8; ++g) { int cnt = 0;
#pragma unroll
            for (int g2 = 0; g2 < 8; ++g2) cnt += (gs[g2] > gs[g] || (gs[g2] == gs[g] && g2 < g)) ? 1 : 0;
            if (cnt < 4) { if (nsel == j) mygrp = g; ++nsel; } }
        float tv[8]; int ti[8];
#pragma unroll
        for (int k = 0; k < 8; ++k) { tv[k] = -INFINITY; ti[k] = 0x7fffffff; }
        { const LAS float* p = row + 32 * mygrp; for (int i = 0; i < 32; ++i) TOP8_INSERT(p[i], 32 * mygrp + i); }
        float ov[3][8]; int oi[3][8];
#pragma unroll
        for (int q = 0; q < 3; ++q)
#pragma unroll
            for (int k = 0; k < 8; ++k) { ov[q][k] = __shfl_xor(tv[k], q + 1); oi[q][k] = __shfl_xor(ti[k], q + 1); }
#pragma unroll
        for (int q = 0; q < 3; ++q)
#pragma unroll
            for (int k = 0; k < 8; ++k) TOP8_INSERT(ov[q][k], oi[q][k]);
        if (j == 0) {
            float sc[8], ssum = 0.f;
#pragma unroll
            for (int k = 0; k < 8; ++k) { sc[k] = tv[k] - rbias[ti[k]]; ssum += sc[k]; }
            const float sinv = 2.5f / ssum;
            unsigned rk[8];
#pragma unroll
            for (int k = 0; k < 8; ++k) rk[k] = __hip_atomic_fetch_add(total + ti[k] * 64, 1u, __ATOMIC_RELAXED, __HIP_MEMORY_SCOPE_AGENT);
            const size_t t = (size_t)(tb + tok);
#pragma unroll
            for (int k = 0; k < 8; ++k) { EIDX[t * 8 + k] = ti[k]; RANK[t * 8 + k] = (int)rk[k]; GWT[t * 8 + k] = sc[k] * sinv; }
        }
    }
}
#undef TOP8_INSERT
DI void build_tab(Frame& F) {
    LAS int* tab = (LAS int*)(F.lds + LDS_TAB); LAS int* ctab = (LAS int*)(F.lds + LDS_TAB + 1040);
    const unsigned* total = (const unsigned*)(F.ws + WS_CTL) + CW_TOTAL;
    const int e = (int)threadIdx.x;
    int tot = 0;
    if (e < NE) tot = (int)total[e * 64];
    __syncthreads();
    if (e < NE) { tab[e] = (tot + 255) >> 8; ctab[e] = tot; }
    __syncthreads();
    int acc = 0, cacc = 0;
    if (e < NE) {
        for (int i = 0; i < NE; i += 4) { const i32x4 a = *(const LAS i32x4*)(tab + i), c = *(const LAS i32x4*)(ctab + i);
#pragma unroll
            for (int j = 0; j < 4; ++j) if (i + j < e) { acc += a[j]; cacc += c[j]; } }
    }
    __syncthreads();
    if (e < NE) { tab[e] = acc; ctab[e] = cacc; if (e == NE - 1) { tab[NE] = acc + ((tot + 255) >> 8); ctab[NE] = cacc + tot; } }
    __syncthreads();
}
DI int find_expert(const LAS int* tab, int blk) {
    int lo = 0, hi = NE - 1;
    while (lo < hi) { const int mid = (lo + hi + 1) >> 1; if (tab[mid] <= blk) lo = mid; else hi = mid - 1; }
    return lo;
}
DI void p6_scatter(Frame& F) {
    unsigned char* ws = F.ws;
    build_tab(F);
    const LAS int* tab = (const LAS int*)(F.lds + LDS_TAB);
    const unsigned* total = (const unsigned*)(ws + WS_CTL) + CW_TOTAL;
    const int* EIDX = (const int*)(ws + WS_EIDX); const int* RANK = (const int*)(ws + WS_RANK); const unsigned* GWTB = (const unsigned*)(ws + WS_GWT); u32x2* RI = (u32x2*)(ws + WS_ROWINFO);
    const int gt = blockIdx.x * 512 + ((int)threadIdx.x), ngt = gridDim.x * 512;
    const LAS int* ctab = (const LAS int*)(F.lds + LDS_TAB + 1040); int* POSC = (int*)(ws + WS_RANK);
    for (int idx = gt; idx < T * 8; idx += ngt) { const int e = EIDX[idx]; const int rk = RANK[idx]; u32x2 v; v.x = (unsigned)idx; v.y = GWTB[idx]; RI[(size_t)tab[e] * 256 + rk] = v;
        POSC[idx] = ctab[e] + rk; }
    { const size_t sbase = (size_t)tab[NE] * 256; for (int t = gt; t < T; t += ngt) { u32x2 v; v.x = (unsigned)t * 8u; v.y = 0u; RI[sbase + t] = v; } }
    for (int idx = gt; idx < NE * 256; idx += ngt) { const int e = idx >> 8, i = idx & 255; const int tot = (int)total[e * 64]; const int padded = ((tot + 255) >> 8) << 8;
        if (tot + i < padded) { u32x2 v; v.x = 0xffffffffu; v.y = 0u; RI[(size_t)tab[e] * 256 + tot + i] = v; } }
}
typedef pg::f32x4 accv;
struct DenseSched {
    static constexpr bool GATHER = false;
    int nM, nN, nwg, G, c; const char* Bt; size_t tstepB;
    DI void init(int M, int N, int K, const bf16* Bt_, int G_, int c_) { nM = M / 256; nN = N / 256; nwg = nM * nN; G = G_; c = c_; Bt = (const char*)Bt_; tstepB = (size_t)256 * K * 2; }
    DI bool next(int i, pg::Unit& u) const {
        const int wgid = pg::xcd_deal(i, G, c, nwg); if (wgid < 0) return false;
        const int nig = pg::WGM * nN, gid = wgid / nig, fm = gid * pg::WGM, gsz = (nM - fm) < pg::WGM ? (nM - fm) : pg::WGM;
        u.pm = fm + ((wgid % nig) % gsz); u.pn = (wgid % nig) / gsz; u.B = Bt + (size_t)u.pn * tstepB; u.kind = 0; u.rb = u.pm; return true;
    }
    DI int arow(const pg::Unit& u, int r) const { return u.pm * 256 + r; }
};
struct Moe1Sched {
    static constexpr bool GATHER = true;
    const LAS int* tab; const u32x2* rowinfo; const char* W13; const char* WS13; int nR, nblk, nwg, G, c;
    DI bool next(int i, pg::Unit& u) const {
        const int L = pg::xcd_deal(i, G, c, nwg); if (L < 0) return false;
        if (L < nR) { const int blk = L >> 1; u.pn = L & 1; u.pm = blk; u.rb = blk; u.kind = 0; const int e = find_expert(tab, blk); u.B = W13 + ((size_t)e * 512 + (size_t)u.pn * 256) * 1024 * 2; }
        else { const int Ls = L - nR; u.pn = Ls & 1; u.rb = Ls >> 1; u.pm = nblk + u.rb; u.kind = 1; u.B = WS13 + (size_t)u.pn * 256 * 1024 * 2; }
        return true;
    }
    DI int arow(const pg::Unit& u, int r) const { const int info = (int)rowinfo[(unsigned)(u.pm * 256 + r)].x; return info < 0 ? 0 : (info >> 3); }
};
struct Moe2Sched {
    static constexpr bool GATHER = false;
    const LAS int* tab; const char* W2; int nblk, G, c;
    DI bool next(int i, pg::Unit& u) const {
        const int blk = pg::xcd_deal(i >> 2, G, c, nblk); if (blk < 0) return false;
        u.pm = blk; u.pn = i & 3; u.rb = blk; u.kind = 0; const int e = find_expert(tab, blk); u.B = W2 + ((size_t)e * 1024 + (size_t)u.pn * 256) * 256 * 2; return true;
    }
    DI int arow(const pg::Unit& u, int r) const { return u.pm * 256 + r; }
};

DI u32x4 pack8(const accv& a, const accv& b) { u32x4 w; w.x = pk2(a[0], a[1]); w.y = pk2(a[2], a[3]); w.z = pk2(b[0], b[1]); w.w = pk2(b[2], b[3]); return w; }
DI accv shfl4(const accv& v, int mask) { accv r; r[0] = __shfl_xor(v[0], mask); r[1] = __shfl_xor(v[1], mask); r[2] = __shfl_xor(v[2], mask); r[3] = __shfl_xor(v[3], mask); return r; }

struct EpiProj {
    static constexpr bool PERM = true; static constexpr int MIDK = -1;
    unsigned char* ws;
    DI void midk(accv (&)[2][2][4][2], const pg::Unit&, int, int, int, int) const {}
    DI void operator()(const accv (&acc)[2][2][4][2], const pg::Unit& u, int wr, int wc, int fr, int fq) const {
        const int pn = u.pn;
        if (pn == 8 && wc != 0) return;
#pragma unroll
        for (int ai = 0; ai < 2; ++ai)
#pragma unroll
            for (int m = 0; m < 4; ++m) {
                const int row = u.pm * 256 + ai * 128 + wr * 64 + m * 16 + fr; const int pos = row & (SEQ - 1);
                if (pn < 4) {
                    bf16* dst = (bf16*)(ws + (pn < 2 ? WS_QD : WS_KD)) + (size_t)row * 512 + (pn & 1) * 256 + wc * 32 + 8 * fq;
                    const float sc = pn < 2 ? CD2 : 1.0f;
                    accv c0, c1, s0, s1;
                    if ((wc & 1) == 0) { const float* tab = (const float*)(ws + WS_ROPE_D) + (size_t)pos * 16;
                        const accv t0 = *(const accv*)(tab), t1 = *(const accv*)(tab + 4), t2 = *(const accv*)(tab + 8), t3 = *(const accv*)(tab + 12);
                        c0 = (accv){t0[0], t0[2], t1[0], t1[2]}; s0 = (accv){t0[1], t0[3], t1[1], t1[3]}; c1 = (accv){t2[0], t2[2], t3[0], t3[2]}; s1 = (accv){t2[1], t2[3], t3[1], t3[3]}; }
#pragma unroll
                    for (int bj = 0; bj < 2; ++bj) {
                        accv v0 = acc[ai][bj][m][0], v1 = acc[ai][bj][m][1];
                        if ((wc & 1) == 0) {
                            const accv p0 = shfl4(v0, 16), p1 = shfl4(v1, 16);
                            if (fq == 0) { v0 = v0 * c0 - p0 * s0; v1 = v1 * c1 - p1 * s1; }
                            else if (fq == 1) { v0 = v0 * c0 + p0 * s0; v1 = v1 * c1 + p1 * s1; }
                        }
                        v0 = v0 * sc; v1 = v1 * sc;
                        *(u32x4*)(dst + bj * 128) = pack8(v0, v1);
                    }
                } else if (pn < 6) {
                    bf16* dst = (bf16*)(ws + WS_VD) + (size_t)row * 512 + (pn - 4) * 256 + wc * 32 + 8 * fq;
#pragma unroll
                    for (int bj = 0; bj < 2; ++bj) *(u32x4*)(dst + bj * 128) = pack8(acc[ai][bj][m][0], acc[ai][bj][m][1]);
                } else if (pn < 8) {
                    bf16* dst = (bf16*)(ws + WS_CQKV) + (size_t)row * 512 + (pn - 6) * 256 + wc * 32 + 8 * fq;
                    float* sq = (float*)(ws + WS_SSQC) + (size_t)row * 16 + (pn - 6) * 8 + wc;
#pragma unroll
                    for (int bj = 0; bj < 2; ++bj) { const accv v0 = acc[ai][bj][m][0], v1 = acc[ai][bj][m][1];
                        float s = (v0[0] * v0[0] + v0[1] * v0[1]) + (v0[2] * v0[2] + v0[3] * v0[3]) + (v1[0] * v1[0] + v1[1] * v1[1]) + (v1[2] * v1[2] + v1[3] * v1[3]);
                        s += __shfl_xor(s, 16); s += __shfl_xor(s, 32);
                        if (fq == 0) sq[bj * 4] = s;
                        *(u32x4*)(dst + bj * 128) = pack8(v0, v1); }
                } else {
                    const float* tab = (const float*)(ws + WS_ROPE_M) + (size_t)pos * 32 + 16 * (fq & 1);
                    const accv t0 = *(const accv*)(tab), t1 = *(const accv*)(tab + 4), t2 = *(const accv*)(tab + 8), t3 = *(const accv*)(tab + 12);
                    const accv c0 = {t0[0], t0[2], t1[0], t1[2]}, s0 = {t0[1], t0[3], t1[1], t1[3]}, c1 = {t2[0], t2[2], t3[0], t3[2]}, s1 = {t2[1], t2[3], t3[1], t3[3]};
                    accv v0 = acc[ai][0][m][0], v1 = acc[ai][0][m][1];
                    const accv p0 = shfl4(v0, 32), p1 = shfl4(v1, 32);
                    if (fq < 2) { v0 = v0 * c0 - p0 * s0; v1 = v1 * c1 - p1 * s1; } else { v0 = v0 * c0 + p0 * s0; v1 = v1 * c1 + p1 * s1; }
                    *(u32x4*)((bf16*)(ws + WS_KPE) + (size_t)row * 32 + 8 * fq) = pack8(v0, v1);
                }
            }
    }
};
struct EpiQ {
    static constexpr bool PERM = true; static constexpr int MIDK = -1;
    unsigned char* ws;
    DI void midk(accv (&)[2][2][4][2], const pg::Unit&, int, int, int, int) const {}
    DI void operator()(const accv (&acc)[2][2][4][2], const pg::Unit& u, int wr, int wc, int fr, int fq) const {
#pragma unroll
        for (int ai = 0; ai < 2; ++ai)
#pragma unroll
            for (int m = 0; m < 4; ++m) {
                const int row = u.pm * 256 + ai * 128 + wr * 64 + m * 16 + fr; const int pos = row & (SEQ - 1);
                const float rq = ((const float*)(ws + WS_RQRK))[(size_t)row * 2];
                const float* tab = (const float*)(ws + WS_ROPE_M) + (size_t)pos * 32 + 16 * (fq & 1);
                const accv t0 = *(const accv*)(tab), t1 = *(const accv*)(tab + 4), t2 = *(const accv*)(tab + 8), t3 = *(const accv*)(tab + 12);
                const accv c0 = {t0[0], t0[2], t1[0], t1[2]}, s0 = {t0[1], t0[3], t1[1], t1[3]}, c1 = {t2[0], t2[2], t3[0], t3[2]}, s1 = {t2[1], t2[3], t3[1], t3[3]};
#pragma unroll
                for (int bj = 0; bj < 2; ++bj) {
                    const int G = 8 * u.pn + 4 * bj + wc;
                    accv v0 = acc[ai][bj][m][0] * rq, v1 = acc[ai][bj][m][1] * rq;
                    if (G % 3 == 2) {
                        const accv p0 = shfl4(v0, 32), p1 = shfl4(v1, 32);
                        if (fq < 2) { v0 = v0 * c0 - p0 * s0; v1 = v1 * c1 - p1 * s1; } else { v0 = v0 * c0 + p0 * s0; v1 = v1 * c1 + p1 * s1; }
                    }
                    *(u32x4*)((bf16*)(ws + WS_QM) + (size_t)row * 768 + 32 * G + 8 * fq) = pack8(v0, v1);
                }
            }
    }
};
struct EpiKV {
    static constexpr bool PERM = true; static constexpr int MIDK = -1;
    unsigned char* ws;
    DI void midk(accv (&)[2][2][4][2], const pg::Unit&, int, int, int, int) const {}
    DI void operator()(const accv (&acc)[2][2][4][2], const pg::Unit& u, int wr, int wc, int fr, int fq) const {
        float sc[2][4];
#pragma unroll
        for (int ai = 0; ai < 2; ++ai)
#pragma unroll
            for (int m = 0; m < 4; ++m) sc[ai][m] = ((const float*)(ws + WS_RQRK))[(size_t)(u.pm * 256 + ai * 128 + wr * 64 + m * 16 + fr) * 2 + 1];
        asm volatile("" : "+v"(sc[0][0]), "+v"(sc[0][1]), "+v"(sc[0][2]), "+v"(sc[0][3]), "+v"(sc[1][0]), "+v"(sc[1][1]), "+v"(sc[1][2]), "+v"(sc[1][3]));
#pragma unroll
        for (int ai = 0; ai < 2; ++ai)
#pragma unroll
            for (int m = 0; m < 4; ++m) {
                const int row = u.pm * 256 + ai * 128 + wr * 64 + m * 16 + fr;
                const float rk = sc[ai][m];
                bf16* dst = (bf16*)(ws + WS_KVM) + (size_t)row * 1024 + u.pn * 256 + wc * 32 + 8 * fq;
#pragma unroll
                for (int bj = 0; bj < 2; ++bj) *(u32x4*)(dst + bj * 128) = pack8(acc[ai][bj][m][0] * rk, acc[ai][bj][m][1] * rk);
            }
    }
};
struct EpiWo {
    static constexpr bool PERM = true; static constexpr int MIDK = 8;
    unsigned char* ws; bf16* mix;
    DI void scales(int row, float& f, float& rm) const { const f32x2 v = *(const f32x2*)((const float*)(ws + WS_RDRM) + (size_t)row * 2); f = v[0]; rm = v[1]; }
    DI void midk(accv (&acc)[2][2][4][2], const pg::Unit& u, int wr, int wc, int fr, int fq) const {
        float sf[2][4];
#pragma unroll
        for (int ai = 0; ai < 2; ++ai)
#pragma unroll
            for (int m = 0; m < 4; ++m) { float rm_; scales(u.pm * 256 + ai * 128 + wr * 64 + m * 16 + fr, sf[ai][m], rm_); }
        asm volatile("" : "+v"(sf[0][0]), "+v"(sf[0][1]), "+v"(sf[0][2]), "+v"(sf[0][3]), "+v"(sf[1][0]), "+v"(sf[1][1]), "+v"(sf[1][2]), "+v"(sf[1][3]));
#pragma unroll
        for (int ai = 0; ai < 2; ++ai)
#pragma unroll
            for (int m = 0; m < 4; ++m) { const float f = sf[ai][m];
#pragma unroll
                for (int bj = 0; bj < 2; ++bj)
#pragma unroll
                    for (int n = 0; n < 2; ++n) acc[ai][bj][m][n] = acc[ai][bj][m][n] * f; }
    }
    DI void operator()(const accv (&acc)[2][2][4][2], const pg::Unit& u, int wr, int wc, int fr, int fq) const {
        float sr[2][4];
#pragma unroll
        for (int ai = 0; ai < 2; ++ai)
#pragma unroll
            for (int m = 0; m < 4; ++m) { float f_; scales(u.pm * 256 + ai * 128 + wr * 64 + m * 16 + fr, f_, sr[ai][m]); }
        asm volatile("" : "+v"(sr[0][0]), "+v"(sr[0][1]), "+v"(sr[0][2]), "+v"(sr[0][3]), "+v"(sr[1][0]), "+v"(sr[1][1]), "+v"(sr[1][2]), "+v"(sr[1][3]));
#pragma unroll
        for (int ai = 0; ai < 2; ++ai)
#pragma unroll
            for (int m = 0; m < 4; ++m) { const int row = u.pm * 256 + ai * 128 + wr * 64 + m * 16 + fr; const float rm = sr[ai][m];
                bf16* dst = mix + (size_t)row * 1024 + u.pn * 256 + wc * 32 + 8 * fq;
#pragma unroll
                for (int bj = 0; bj < 2; ++bj) *(u32x4*)(dst + bj * 128) = pack8(acc[ai][bj][m][0] * rm, acc[ai][bj][m][1] * rm); }
    }
};
struct EpiRouter {
    static constexpr bool PERM = false; static constexpr int MIDK = -1;
    float* lg;
    DI void midk(accv (&)[2][2][4][2], const pg::Unit&, int, int, int, int) const {}
    DI void operator()(const accv (&acc)[2][2][4][2], const pg::Unit& u, int wr, int wc, int fr, int fq) const {
#pragma unroll
        for (int ai = 0; ai < 2; ++ai)
#pragma unroll
            for (int m = 0; m < 4; ++m) { const int row = u.pm * 256 + ai * 128 + wr * 64 + m * 16 + fr; float* p = lg + (size_t)row * 256 + wc * 32 + 4 * fq;
#pragma unroll
                for (int bj = 0; bj < 2; ++bj)
#pragma unroll
                    for (int n = 0; n < 2; ++n) *(accv*)(p + bj * 128 + n * 16) = acc[ai][bj][m][n]; }
    }
};
DI float silu1(float a) { return a * __builtin_amdgcn_rcpf(1.0f + __builtin_amdgcn_exp2f(a * -LOG2E)); }
DI accv silu4(const accv& a) { accv r; r[0] = silu1(a[0]); r[1] = silu1(a[1]); r[2] = silu1(a[2]); r[3] = silu1(a[3]); return r; }
struct EpiGate {
    static constexpr bool PERM = true; static constexpr int MIDK = -1;
    bf16* hb; bf16* hs;
    DI void midk(accv (&)[2][2][4][2], const pg::Unit&, int, int, int, int) const {}
    DI void operator()(const accv (&acc)[2][2][4][2], const pg::Unit& u, int wr, int wc, int fr, int fq) const {
        bf16* base = (u.kind ? hs : hb) + (size_t)u.rb * 256 * 256 + u.pn * 128 + wc * 32 + 8 * fq;
#pragma unroll
        for (int ai = 0; ai < 2; ++ai)
#pragma unroll
            for (int m = 0; m < 4; ++m) { const int r = ai * 128 + wr * 64 + m * 16 + fr;
                const accv h0 = silu4(acc[ai][0][m][0]) * acc[ai][1][m][0], h1 = silu4(acc[ai][0][m][1]) * acc[ai][1][m][1];
                *(u32x4*)(base + (size_t)r * 256) = pack8(h0, h1); }
    }
};
struct EpiShared2 {
    static constexpr bool PERM = true; static constexpr int MIDK = -1;
    bf16* shb;
    DI void midk(accv (&)[2][2][4][2], const pg::Unit&, int, int, int, int) const {}
    DI void operator()(const accv (&acc)[2][2][4][2], const pg::Unit& u, int wr, int wc, int fr, int fq) const {
#pragma unroll
        for (int ai = 0; ai < 2; ++ai)
#pragma unroll
            for (int m = 0; m < 4; ++m) { const int row = u.pm * 256 + ai * 128 + wr * 64 + m * 16 + fr; bf16* dst = shb + (size_t)row * H1_LD + u.pn * 256 + wc * 32 + 8 * fq;
#pragma unroll
                for (int bj = 0; bj < 2; ++bj) *(u32x4*)(dst + bj * 128) = pack8(acc[ai][bj][m][0], acc[ai][bj][m][1]); }
    }
};
constexpr float Y2_SCALE = 32.0f;
DI u32x2 pack8_fp8(const accv& a, const accv& b) { int w0 = 0, w1 = 0;
    w0 = __builtin_amdgcn_cvt_pk_fp8_f32(a[0], a[1], w0, false); w0 = __builtin_amdgcn_cvt_pk_fp8_f32(a[2], a[3], w0, true);
    w1 = __builtin_amdgcn_cvt_pk_fp8_f32(b[0], b[1], w1, false); w1 = __builtin_amdgcn_cvt_pk_fp8_f32(b[2], b[3], w1, true);
    u32x2 r; r.x = (unsigned)w0; r.y = (unsigned)w1; return r; }
struct EpiY2 {
    static constexpr bool PERM = true; static constexpr int MIDK = -1;
    const u32x2* rowinfo; unsigned char* y2c;
    DI void midk(accv (&)[2][2][4][2], const pg::Unit&, int, int, int, int) const {}
    DI void operator()(const accv (&acc)[2][2][4][2], const pg::Unit& u, int wr, int wc, int fr, int fq) const {
        u32x2 iw[2][4];
#pragma unroll
        for (int ai = 0; ai < 2; ++ai)
#pragma unroll
            for (int m = 0; m < 4; ++m) iw[ai][m] = rowinfo[(unsigned)(u.rb * 256 + ai * 128 + wr * 64 + m * 16 + fr)];
#pragma unroll
        for (int ai = 0; ai < 2; ++ai)
#pragma unroll
            for (int m = 0; m < 4; ++m) { const int info = (int)iw[ai][m][0];
                if (info >= 0) { const float w = __uint_as_float(iw[ai][m][1]) * Y2_SCALE;     unsigned char* dst = y2c + (size_t)info * 1024 + u.pn * 256 + wc * 32 + 8 * fq;
#pragma unroll
                    for (int bj = 0; bj < 2; ++bj) *(u32x2*)(dst + bj * 128) = pack8_fp8(acc[ai][bj][m][0] * w, acc[ai][bj][m][1] * w); } }
    }
};

DI void p1_proj(Frame& F) {
    DenseSched S; S.init(T, 2304, 1024, (const bf16*)(F.ws + WS_W_IN_T), gridDim.x, blockIdx.x);
    EpiProj E{F.ws};
    pg::gemm_phase<EpiProj, DenseSched>(F.lds, (const char*)(F.ws + WS_XB), 1024, 1024, S, E);
}
DI void rqrk_panel(Frame& F, int pm) {
    const int r = ((int)threadIdx.x) & 255, half = ((int)threadIdx.x) >> 8; const size_t row = (size_t)pm * 256 + r;
    const float* sq = (const float*)(F.ws + WS_SSQC) + row * 16; float v;
    if (half == 0) { const f32x4 a = *(const f32x4*)sq, b = *(const f32x4*)(sq + 4), c = *(const f32x4*)(sq + 8);
        v = CM2 / sqrtf((((a.x + a.y) + (a.z + a.w)) + ((b.x + b.y) + (b.z + b.w)) + ((c.x + c.y) + (c.z + c.w))) * (1.0f / 384.0f) + RMS_EPS); }
    else { const f32x4 d = *(const f32x4*)(sq + 12); v = 1.0f / sqrtf(((d.x + d.y) + (d.z + d.w)) * (1.0f / 128.0f) + RMS_EPS); }
    ((float*)(F.ws + WS_RQRK))[row * 2 + half] = v;
}
constexpr int KV2_ROW = 272, KV2_HALF = 512 * KV2_ROW;
DI void p2b_kv_v2(Frame& F) {
    unsigned char* ws = F.ws;
    int tid = threadIdx.x; asm volatile("" : "+v"(tid));
    const int lane = tid & 63, l31 = lane & 31, h = lane >> 5, w = __builtin_amdgcn_readfirstlane(tid >> 6);
    LAS unsigned char* lds = F.lds;
    const char* wbase = (const char*)(ws + WS_W_UKV_T);
    const unsigned boff = (unsigned)(l31 * KV2_ROW + h * 16);
    f32x16 zero;
#pragma unroll
    for (int r = 0; r < 16; ++r) zero[r] = 0.f;
    for (int k = 0;; ++k) {
        const int blk = pg::xcd_deal(k, gridDim.x, blockIdx.x, T / 256); if (blk < 0) break;
        const size_t row = (size_t)blk * 256 + 32 * w + l31;
        bf16x8 af[8]; float rk;
        { const bf16* ap = (const bf16*)(ws + WS_CQKV) + row * 512 + 384 + 8 * h;
#pragma unroll
          for (int s_ = 0; s_ < 8; ++s_) asm volatile("global_load_dwordx4 %0, %1, off offset:%2" : "=v"(af[s_]) : "v"(ap), "i"(32 * s_) : "memory");
          const float* rp = (const float*)(ws + WS_RQRK) + row * 2 + 1; asm volatile("global_load_dword %0, %1, off" : "=v"(rk) : "v"(rp) : "memory"); }
        bf16* yrow = (bf16*)(ws + WS_KVM) + row * 1024 + 8 * h;
        for (int hf = 0; hf < 2; ++hf) {
            if (hf) { asm volatile("s_waitcnt lgkmcnt(0)" ::: "memory"); __builtin_amdgcn_s_barrier(); asm volatile("" ::: "memory"); }
            for (int i = 0; i < 17; ++i) { const int j = w + 8 * i, byte = 1024 * j + 16 * lane, r_ = byte / KV2_ROW; int cc = (byte % KV2_ROW) >> 4; cc = cc < 16 ? cc : 0;
                __builtin_amdgcn_global_load_lds((const unsigned*)(wbase + (size_t)(512 * hf + r_) * 512 + 256 + cc * 16), (LAS unsigned*)(lds + 1024 * j), 16, 0, 0); }
            asm volatile("s_waitcnt vmcnt(0)" : "+v"(af[0]), "+v"(af[1]), "+v"(af[2]), "+v"(af[3]), "+v"(af[4]), "+v"(af[5]), "+v"(af[6]), "+v"(af[7]), "+v"(rk) :: "memory");
            __builtin_amdgcn_s_barrier(); asm volatile("" ::: "memory");
#pragma unroll 1
            for (int cg = 0; cg < 8; ++cg) {
                f32x16 acc0, acc1;
                const unsigned baddr = (unsigned)(size_t)lds + (unsigned)(cg * 64 * KV2_ROW) + boff;
                bf16x8 b0[2][4], b1[2][4];
#define KV2_LDB(buf_, sb_) do { _Pragma("unroll") for (int q_ = 0; q_ < 4; ++q_) { \
                    asm volatile("ds_read_b128 %0, %1 offset:%2" : "=v"(b0[buf_][q_]) : "v"(baddr), "i"((4 * (sb_) + q_) * 32) : "memory"); \
                    asm volatile("ds_read_b128 %0, %1 offset:%2" : "=v"(b1[buf_][q_]) : "v"(baddr), "i"(32 * KV2_ROW + (4 * (sb_) + q_) * 32) : "memory"); } } while (0)
#define KV2_TIE(buf_) "+v"(b0[buf_][0]), "+v"(b0[buf_][1]), "+v"(b0[buf_][2]), "+v"(b0[buf_][3]), "+v"(b1[buf_][0]), "+v"(b1[buf_][1]), "+v"(b1[buf_][2]), "+v"(b1[buf_][3])
                KV2_LDB(0, 0); KV2_LDB(1, 1);
                asm volatile("s_waitcnt lgkmcnt(8)" : KV2_TIE(0) :: "memory");
#pragma unroll
                for (int q = 0; q < 4; ++q) { acc0 = MFMA32(b0[0][q], af[q], q == 0 ? zero : acc0); acc1 = MFMA32(b1[0][q], af[q], q == 0 ? zero : acc1); }
                asm volatile("s_waitcnt lgkmcnt(0)" : KV2_TIE(1) :: "memory");
#pragma unroll
                for (int q = 0; q < 4; ++q) { acc0 = MFMA32(b0[1][q], af[4 + q], acc0); acc1 = MFMA32(b1[1][q], af[4 + q], acc1); }
#undef KV2_LDB
#undef KV2_TIE
#pragma unroll
                for (int ct = 0; ct < 2; ++ct) {
                    const f32x16& acc = ct ? acc1 : acc0;
                    unsigned d[4][2];
#pragma unroll
                    for (int g = 0; g < 4; ++g) { d[g][0] = pk2(acc[4 * g] * rk, acc[4 * g + 1] * rk); d[g][1] = pk2(acc[4 * g + 2] * rk, acc[4 * g + 3] * rk); }
#pragma unroll
                    for (int pc = 0; pc < 2; ++pc) {
                        const auto s0 = __builtin_amdgcn_permlane32_swap(d[2 * pc][0], d[2 * pc + 1][0], false, false);
                        const auto s1 = __builtin_amdgcn_permlane32_swap(d[2 * pc][1], d[2 * pc + 1][1], false, false);
                        u32x4 o; o[0] = s0[0]; o[1] = s1[0]; o[2] = s0[1]; o[3] = s1[1];
                        *(u32x4*)(yrow + 512 * hf + 64 * cg + 32 * ct + 16 * pc) = o;
                    }
                }
            }
        }
        asm volatile("s_waitcnt vmcnt(0) lgkmcnt(0)" ::: "memory");
        __builtin_amdgcn_s_barrier(); asm volatile("" ::: "memory");
    }
}
DI void p2_up(Frame& F) {
    DenseSched Sq; Sq.init(T, 768, 384, (const bf16*)(F.ws + WS_W_UQ_T), gridDim.x, blockIdx.x);
    { pg::Unit u; for (int i = 0; Sq.next(i, u); ++i) rqrk_panel(F, u.pm);
      for (int k = 0;; ++k) { const int blk = pg::xcd_deal(k, gridDim.x, blockIdx.x, T / 256); if (blk < 0) break; rqrk_panel(F, blk); } }
    asm volatile("s_waitcnt vmcnt(0)" ::: "memory"); __syncthreads();
    { EpiQ E{F.ws}; pg::gemm_phase<EpiQ, DenseSched>(F.lds, (const char*)(F.ws + WS_CQKV), 512, 384, Sq, E); }
    for (int rep = 0; rep < REP_P2B; ++rep) p2b_kv_v2(F);
}
DI void p4_wo(Frame& F) {
    DenseSched S; S.init(T, 1024, 1024, (const bf16*)(F.ws + WS_W_O_T), gridDim.x, blockIdx.x);
    EpiWo E{F.ws, (bf16*)(F.ws + WS_MIXB)};
    pg::gemm_phase<EpiWo, DenseSched>(F.lds, (const char*)(F.ws + WS_Y), 1024, 1024, S, E);
}
DI void p5b_router(Frame& F) {
    DenseSched S; S.init(T, 256, 1024, (const bf16*)(F.ws + WS_W_R), gridDim.x, blockIdx.x);
    EpiRouter E{(float*)(F.ws + WS_LOGITS)};
    pg::gemm_phase<EpiRouter, DenseSched>(F.lds, (const char*)F.out, H1_LD, 1024, S, E);
}
DI void p7_gemm1(Frame& F) {
    build_tab(F);
    const LAS int* tab = (const LAS int*)(F.lds + LDS_TAB);
    Moe1Sched S; S.tab = tab; S.rowinfo = (const u32x2*)(F.ws + WS_ROWINFO); S.W13 = (const char*)(F.ws + WS_W13_T); S.WS13 = (const char*)(F.ws + WS_WS13_T);
    S.nblk = tab[NE]; S.nR = S.nblk * 2; S.nwg = S.nR + (T / 256) * 2; S.G = gridDim.x; S.c = blockIdx.x;
    EpiGate E{(bf16*)(F.ws + WS_HB), (bf16*)(F.ws + WS_HS)};
    pg::gemm_phase<EpiGate, Moe1Sched>(F.lds, (const char*)F.out, H1_LD, 1024, S, E);
}
DI void p8s_shared2(Frame& F) {
    DenseSched S; S.init(T, 1024, 256, (const bf16*)(F.ws + WS_WS2_T), gridDim.x, blockIdx.x);
    EpiShared2 E{(bf16*)F.out + 1024};
    pg::gemm_phase<EpiShared2, DenseSched>(F.lds, (const char*)(F.ws + WS_HS), 256, 256, S, E);
}
DI void p8_gemm2(Frame& F) {
    build_tab(F);
    const LAS int* tab = (const LAS int*)(F.lds + LDS_TAB);
    Moe2Sched S; S.tab = tab; S.W2 = (const char*)(F.ws + WS_W2_T); S.nblk = tab[NE]; S.G = gridDim.x; S.c = blockIdx.x;
    EpiY2 E{(const u32x2*)(F.ws + WS_ROWINFO), (unsigned char*)(F.ws + WS_Y2C)};
    pg::gemm_phase<EpiY2, Moe2Sched>(F.lds, (const char*)(F.ws + WS_HB), 256, 256, S, E);
}
constexpr int G2_ROW = 528, G2_TILE = 64 * G2_ROW;
template <int MODE>
DI void p8_gemm2_v2(Frame& F) {
    build_tab(F);
    const LAS int* tab = (const LAS int*)(F.lds + LDS_TAB);
    const int nblk = tab[NE];
    unsigned char* ws = F.ws;
    int tid = threadIdx.x; asm volatile("" : "+v"(tid));
    const int lane = tid & 63, l31 = lane & 31, h = lane >> 5, w = __builtin_amdgcn_readfirstlane(tid >> 6);
    LAS unsigned char* lds = F.lds;
    const u32x2* ROWI = (const u32x2*)(ws + WS_ROWINFO); unsigned char* Y2 = ws + WS_Y2C;
    unsigned poff[5], pdst[5];
#pragma unroll
    for (int i = 0; i < 5; ++i) { int j = w + 8 * i; if (j >= 33) j -= 8; const int byte = 1024 * j + 16 * lane, row = byte / G2_ROW; int cc = (byte % G2_ROW) >> 4; cc = cc < 32 ? cc : 0;
        poff[i] = (unsigned)(row * 512 + cc * 16); pdst[i] = (unsigned)(1024 * j); }
#define G2_DMA(wbase_, tile_, slot_) do { _Pragma("unroll") for (int i_ = 0; i_ < 5; ++i_) \
        __builtin_amdgcn_global_load_lds((const unsigned*)((wbase_) + (size_t)(tile_) * (64 * 512) + poff[i_]), (LAS unsigned*)(lds + (slot_) * G2_TILE + __builtin_amdgcn_readfirstlane(pdst[i_])), 16, 0, 0); } while (0)
    const unsigned boff = (unsigned)(l31 * G2_ROW + h * 16);
    f32x16 zero;
#pragma unroll
    for (int r = 0; r < 16; ++r) zero[r] = 0.f;
    for (int k = 0;; ++k) {
        const int blk = pg::xcd_deal(k, gridDim.x, blockIdx.x, nblk); if (blk < 0) break;
        const int e = find_expert(tab, blk);
        const char* wbase = (const char*)(ws + WS_W2_T) + (size_t)e * 1024 * 512;
        bf16x8 af[16];
        { const bf16* ap = (const bf16*)(ws + WS_HB) + ((size_t)blk * 256 + 32 * w + l31) * 256 + 8 * h;
#pragma unroll
          for (int s_ = 0; s_ < 16; ++s_) asm volatile("global_load_dwordx4 %0, %1, off offset:%2" : "=v"(af[s_]) : "v"(ap), "i"(32 * s_) : "memory"); }
        u32x2 iw; { const u32x2* ip = ROWI + (unsigned)(blk * 256 + 32 * w + l31); asm volatile("global_load_dwordx2 %0, %1, off" : "=v"(iw) : "v"(ip) : "memory"); }
        G2_DMA(wbase, 0, 0); G2_DMA(wbase, 1, 1);
        asm volatile("s_waitcnt vmcnt(5)" : "+v"(af[0]), "+v"(af[1]), "+v"(af[2]), "+v"(af[3]), "+v"(af[4]), "+v"(af[5]), "+v"(af[6]), "+v"(af[7]), "+v"(af[8]), "+v"(af[9]), "+v"(af[10]), "+v"(af[11]),
                     "+v"(af[12]), "+v"(af[13]), "+v"(af[14]), "+v"(af[15]), "+v"(iw) :: "memory");
        __builtin_amdgcn_s_barrier(); asm volatile("" ::: "memory");
        const int info = (int)iw[0]; const float gsc = __uint_as_float(iw[1]) * Y2_SCALE;
        const int crow0 = ((const LAS int*)(F.lds + LDS_TAB + 1040))[e] + (blk - tab[e]) * 256 + 32 * w + l31;
        unsigned char* yrow = ((info < 0 || MODE >= 1) ? ws + WS_END + 64 * 1024 * w : Y2 + (size_t)crow0 * 1024) + 16 * h;
        int slot = 0;
        for (int t = 0; t < 16; ++t) {
            { int s2 = slot + 2; s2 = s2 >= 3 ? s2 - 3 : s2; const int tn = t + 2 < 16 ? t + 2 : t; G2_DMA(wbase, tn, s2); }
            u32x4 pend0, pend1;
            {
                f32x16 acc0, acc1;
                const unsigned baddr = (unsigned)(size_t)(lds + slot * G2_TILE) + boff;
                bf16x8 b0[2][4], b1[2][4];
#define G2_LDB(buf_, sb_) do { _Pragma("unroll") for (int q_ = 0; q_ < 4; ++q_) { \
                    asm volatile("ds_read_b128 %0, %1 offset:%2" : "=v"(b0[buf_][q_]) : "v"(baddr), "i"((4 * (sb_) + q_) * 32) : "memory"); \
                    asm volatile("ds_read_b128 %0, %1 offset:%2" : "=v"(b1[buf_][q_]) : "v"(baddr), "i"(32 * G2_ROW + (4 * (sb_) + q_) * 32) : "memory"); } } while (0)
#define G2_TIE(buf_) "+v"(b0[buf_][0]), "+v"(b0[buf_][1]), "+v"(b0[buf_][2]), "+v"(b0[buf_][3]), "+v"(b1[buf_][0]), "+v"(b1[buf_][1]), "+v"(b1[buf_][2]), "+v"(b1[buf_][3])
                G2_LDB(0, 0);
#pragma unroll
                for (int sb = 0; sb < 4; ++sb) {
                    if (sb < 3) { if (sb & 1) G2_LDB(0, sb + 1); else G2_LDB(1, sb + 1); }
                    if (sb < 3) { if (sb & 1) asm volatile("s_waitcnt lgkmcnt(8)" : G2_TIE(1) :: "memory"); else asm volatile("s_waitcnt lgkmcnt(8)" : G2_TIE(0) :: "memory"); }
                    else asm volatile("s_waitcnt lgkmcnt(0)" : G2_TIE(1) :: "memory");
#pragma unroll
                    for (int q = 0; q < 4; ++q) { acc0 = MFMA32(b0[sb & 1][q], af[4 * sb + q], (sb == 0 && q == 0) ? zero : acc0); acc1 = MFMA32(b1[sb & 1][q], af[4 * sb + q], (sb == 0 && q == 0) ? zero : acc1); }
                }
#undef G2_LDB
#undef G2_TIE
#pragma unroll
                for (int ct = 0; ct < 2; ++ct) {
                    if (MODE == 5) { if (acc0[0] == 12345.f && acc1[0] == 54321.f) *(float*)(yrow) = 1.f; continue; }
                    const f32x16& acc = ct ? acc1 : acc0;
                    unsigned d[4];
#pragma unroll
                    for (int g = 0; g < 4; ++g) { int w8 = 0; w8 = __builtin_amdgcn_cvt_pk_fp8_f32(acc[4 * g] * gsc, acc[4 * g + 1] * gsc, w8, false); w8 = __builtin_amdgcn_cvt_pk_fp8_f32(acc[4 * g + 2] * gsc, acc[4 * g + 3] * gsc, w8, true); d[g] = (unsigned)w8; }
                    const auto sA = __builtin_amdgcn_permlane32_swap(d[0], d[2], false, false);
                    const auto sB = __builtin_amdgcn_permlane32_swap(d[1], d[3], false, false);
                    u32x4 o; o[0] = sA[0]; o[1] = sA[1]; o[2] = sB[0]; o[3] = sB[1];
                    if (ct) pend1 = o; else pend0 = o;
                }
            }
            asm volatile("s_waitcnt vmcnt(5) lgkmcnt(0)" : "+v"(pend0), "+v"(pend1) :: "memory");
            *(u32x4*)(yrow + 64 * t) = pend0; *(u32x4*)(yrow + 64 * t + 32) = pend1;
            __builtin_amdgcn_s_barrier(); asm volatile("" ::: "memory");
            slot = slot == 2 ? 0 : slot + 1;
        }
        asm volatile("s_waitcnt vmcnt(0)" ::: "memory");
    }
#undef G2_DMA
}

DI void softmax_pv(f32x16& s, float& m, float& l, f32x16& o0, f32x16& o1, const LAS unsigned char* vl, int lane, int h) {
    float mx = s[0];
#pragma unroll
    for (int r = 1; r < 16; ++r) mx = fmaxf(mx, s[r]);
    mx = fmaxf(mx, __shfl_xor(mx, 32));
    const float mn = fmaxf(m, mx);
    const float alpha = __builtin_amdgcn_exp2f(m - mn);
    float ls = 0.f;
#pragma unroll
    for (int r = 0; r < 16; ++r) { s[r] = __builtin_amdgcn_exp2f(s[r] - mn); ls += s[r]; }
    l = l * alpha + ls; m = mn;
#pragma unroll
    for (int r = 0; r < 16; ++r) { o0[r] *= alpha; o1[r] *= alpha; }
    u32x4 p0, p1;
    p0.x = pk2(s[0], s[1]); p0.y = pk2(s[2], s[3]); p0.z = pk2(s[4], s[5]); p0.w = pk2(s[6], s[7]);
    p1.x = pk2(s[8], s[9]); p1.y = pk2(s[10], s[11]); p1.z = pk2(s[12], s[13]); p1.w = pk2(s[14], s[15]);
    const bf16x8 pf0 = __builtin_bit_cast(bf16x8, p0), pf1 = __builtin_bit_cast(bf16x8, p1);
    const int q4 = (lane & 15) >> 2, p4 = lane & 3, blk = (lane >> 4) & 1;
    const LAS unsigned char* vb = vl + (4 * h + q4) * 144 + (16 * blk + 4 * p4) * 2;
#pragma unroll
    for (int sp = 0; sp < 2; ++sp) {
#pragma unroll
        for (int dt = 0; dt < 2; ++dt) {
            const s16x4 lo = tr_read(vb + (16 * sp) * 144 + dt * 64);
            const s16x4 hi = tr_read(vb + (16 * sp + 8) * 144 + dt * 64);
            const bf16x8 vf = __builtin_shufflevector(lo, hi, 0, 1, 2, 3, 4, 5, 6, 7);
            if (dt == 0) o0 = MFMA32(vf, sp ? pf1 : pf0, o0); else o1 = MFMA32(vf, sp ? pf1 : pf0, o1);
        }
    }
}


constexpr int XP_TILES = (NE + 1) * 192;
constexpr int XP_LDS = 4 * (64 * 208 + 64 * 144);
struct Xpose { f32x4 v[16]; const float *w1, *w3, *w2, *s1, *s3, *s2; int next, cur, tick; bool pend; };
DI void xpose_addr(Frame& F, const Xpose& X, int it, const float*& W, int& ldn, int& k0, int& n0, bf16*& dst, int& Kd) {
    const int e = it / 192, q = it % 192, m = q >> 6, qq = q & 63;
    const float* base;
    const float *pw1 = X.w1, *pw3 = X.w3, *pw2 = X.w2, *ps1 = X.s1, *ps3 = X.s3, *ps2 = X.s2;
    asm volatile("" : "+s"(pw1), "+s"(pw3), "+s"(pw2), "+s"(ps1), "+s"(ps3), "+s"(ps2));
    if (e == NE) base = (m == 0) ? ps1 : (m == 1 ? ps3 : ps2);
    else base = ((m == 0) ? pw1 : (m == 1 ? pw3 : pw2)) + (size_t)e * 1024 * 256;
    W = base;
    if (m < 2) { const int kb = qq >> 2, nb = qq & 3; n0 = 64 * nb; k0 = 64 * kb; ldn = 256; Kd = 1024; const int drow = 256 * (n0 >> 7) + 128 * m + (n0 & 127);
        dst = ((e == NE) ? (bf16*)(F.ws + WS_WS13_T) : (bf16*)(F.ws + WS_W13_T) + (size_t)e * 512 * 1024) + (size_t)drow * 1024; }
    else { const int kb = qq >> 4, nb = qq & 15; n0 = 64 * nb; k0 = 64 * kb; ldn = 1024; Kd = 256;
        dst = ((e == NE) ? (bf16*)(F.ws + WS_WS2_T) : (bf16*)(F.ws + WS_W2_T) + (size_t)e * 1024 * 256) + (size_t)n0 * 256; }
}
DI void xpose_issue(Frame& F, Xpose& X) {
    const int lane = (int)threadIdx.x & 63;
    const float* W; int ldn, k0, n0, Kd; bf16* dst; xpose_addr(F, X, X.next, W, ldn, k0, n0, dst, Kd);
    const float* src = W + (size_t)(k0 + (lane >> 4)) * ldn + n0 + 4 * (lane & 15);
#pragma unroll
    for (int i = 0; i < 16; ++i) X.v[i] = *(const f32x4*)(src + (size_t)(4 * i) * ldn);
    X.cur = X.next; X.next += gridDim.x * 8; X.pend = true;
}
DI void xpose_finish(Frame& F, Xpose& X) {
    const int lane = (int)threadIdx.x & 63;
    const float* W; int ldn, k0, n0, Kd; bf16* dst; xpose_addr(F, X, X.cur, W, ldn, k0, n0, dst, Kd);
    const unsigned wa = (unsigned)(size_t)(F.lds + XP_LDS + F.wave * (16 * 68 * 4)) + (unsigned)(((lane >> 4) * 68 + 4 * (lane & 15)) * 4);
    const unsigned ra = (unsigned)(size_t)(F.lds + XP_LDS + F.wave * (16 * 68 * 4)) + 4u * lane;
#pragma unroll
    for (int c = 0; c < 4; ++c) {
#pragma unroll
        for (int i = 0; i < 4; ++i) asm volatile("ds_write_b128 %0, %1 offset:%2" :: "v"(wa), "v"(X.v[4 * c + i]), "i"(4 * i * 68 * 4) : "memory");
        float p[16];
#pragma unroll
        for (int k = 0; k < 16; ++k) asm volatile("ds_read_b32 %0, %1 offset:%2" : "=v"(p[k]) : "v"(ra), "i"(k * 68 * 4) : "memory");
        asm volatile("s_waitcnt lgkmcnt(0)" : "+v"(p[0]), "+v"(p[1]), "+v"(p[2]), "+v"(p[3]), "+v"(p[4]), "+v"(p[5]), "+v"(p[6]), "+v"(p[7]),
                     "+v"(p[8]), "+v"(p[9]), "+v"(p[10]), "+v"(p[11]), "+v"(p[12]), "+v"(p[13]), "+v"(p[14]), "+v"(p[15]) :: "memory");
        u32x4 o0, o1;
        o0.x = pk2(p[0], p[1]); o0.y = pk2(p[2], p[3]); o0.z = pk2(p[4], p[5]); o0.w = pk2(p[6], p[7]);
        o1.x = pk2(p[8], p[9]); o1.y = pk2(p[10], p[11]); o1.z = pk2(p[12], p[13]); o1.w = pk2(p[14], p[15]);
        bf16* d = dst + (size_t)lane * Kd + k0 + 16 * c;
        *(u32x4*)d = o0; *(u32x4*)(d + 8) = o1;
    }
    X.pend = false;
}
template <int EVERY> DI void xpose_step(Frame& F, Xpose& X) {
    if (X.pend) xpose_finish(F, X);
    if (X.next < XP_TILES && (X.tick % EVERY) == 0) xpose_issue(F, X);
    ++X.tick;
    asm volatile("" ::: "memory");
}

constexpr int ATT_VROW = 144;
constexpr float SM_THR = 8.0f;
DI float max3f(float a, float b, float c) { float r; asm("v_max3_f32 %0, %1, %2, %3" : "=v"(r) : "v"(a), "v"(b), "v"(c)); return r; }
DI void softmax_pv64(f32x16& s0, f32x16& s1, float& m, f32x16& negm, bool& seen, float& l, f32x16& o0, f32x16& o1, const unsigned vaddr) {
    s16x4 va0[4], va1[4], vb0[4], vb1[4];
#pragma unroll
    for (int sp = 0; sp < 4; ++sp) {
        asm volatile("ds_read_b64_tr_b16 %0, %1 offset:%2" : "=v"(va0[sp]) : "v"(vaddr), "i"((16 * sp) * ATT_VROW) : "memory");
        asm volatile("ds_read_b64_tr_b16 %0, %1 offset:%2" : "=v"(va1[sp]) : "v"(vaddr), "i"((16 * sp + 8) * ATT_VROW) : "memory");
        asm volatile("ds_read_b64_tr_b16 %0, %1 offset:%2" : "=v"(vb0[sp]) : "v"(vaddr), "i"((16 * sp) * ATT_VROW + 64) : "memory");
        asm volatile("ds_read_b64_tr_b16 %0, %1 offset:%2" : "=v"(vb1[sp]) : "v"(vaddr), "i"((16 * sp + 8) * ATT_VROW + 64) : "memory"); }
    float a = max3f(s0[0], s0[1], s1[0]), bq = max3f(s0[2], s0[3], s1[1]); a = max3f(a, s1[2], s1[3]);
#pragma unroll
    for (int r = 4; r < 16; r += 4) { a = max3f(a, s0[r], s0[r + 1]); bq = max3f(bq, s0[r + 2], s0[r + 3]); a = max3f(a, s1[r], s1[r + 1]); bq = max3f(bq, s1[r + 2], s1[r + 3]); }
    float mx = fmaxf(a, bq);
    { auto rr = __builtin_amdgcn_permlane32_swap(__float_as_uint(mx), __float_as_uint(mx), false, false); mx = fmaxf(__uint_as_float(rr[0]), __uint_as_float(rr[1])); }
    const bool valid = mx > -1e29f;
    const float dl = seen ? (mx > SM_THR ? mx : 0.f) : (valid ? mx : 0.f);
    seen = seen || valid;
    if (__any(dl != 0.f)) {
        m += dl;
#pragma unroll
        for (int r = 0; r < 16; ++r) { s0[r] -= dl; s1[r] -= dl; }
        const float alpha = __builtin_amdgcn_exp2f(-fmaxf(dl, 0.f));
        l *= alpha;
#pragma unroll
        for (int r = 0; r < 16; ++r) { o0[r] *= alpha; o1[r] *= alpha; negm[r] = -m; }
    }
#pragma unroll
    for (int r = 0; r < 16; ++r) { s0[r] = __builtin_amdgcn_exp2f(s0[r]); s1[r] = __builtin_amdgcn_exp2f(s1[r]); }
    f32x2 acc2 = {0.f, 0.f};
#pragma unroll
    for (int r = 0; r < 16; r += 2) { acc2 = acc2 + (f32x2){s0[r], s0[r + 1]}; acc2 = acc2 + (f32x2){s1[r], s1[r + 1]}; }
    l += acc2[0] + acc2[1];
    u32x4 pw[4];
    pw[0].x = pk2(s0[0], s0[1]); pw[0].y = pk2(s0[2], s0[3]); pw[0].z = pk2(s0[4], s0[5]); pw[0].w = pk2(s0[6], s0[7]);
    pw[1].x = pk2(s0[8], s0[9]); pw[1].y = pk2(s0[10], s0[11]); pw[1].z = pk2(s0[12], s0[13]); pw[1].w = pk2(s0[14], s0[15]);
    pw[2].x = pk2(s1[0], s1[1]); pw[2].y = pk2(s1[2], s1[3]); pw[2].z = pk2(s1[4], s1[5]); pw[2].w = pk2(s1[6], s1[7]);
    pw[3].x = pk2(s1[8], s1[9]); pw[3].y = pk2(s1[10], s1[11]); pw[3].z = pk2(s1[12], s1[13]); pw[3].w = pk2(s1[14], s1[15]);
    asm volatile("s_waitcnt lgkmcnt(0)" : "+v"(va0[0]), "+v"(va1[0]), "+v"(vb0[0]), "+v"(vb1[0]), "+v"(va0[1]), "+v"(va1[1]), "+v"(vb0[1]), "+v"(vb1[1]),
                 "+v"(va0[2]), "+v"(va1[2]), "+v"(vb0[2]), "+v"(vb1[2]), "+v"(va0[3]), "+v"(va1[3]), "+v"(vb0[3]), "+v"(vb1[3]) :: "memory");
#pragma unroll
    for (int sp = 0; sp < 4; ++sp) { const bf16x8 pf = __builtin_bit_cast(bf16x8, pw[sp]);
        o0 = MFMA32(__builtin_shufflevector(va0[sp], va1[sp], 0, 1, 2, 3, 4, 5, 6, 7), pf, o0);
        o1 = MFMA32(__builtin_shufflevector(vb0[sp], vb1[sp], 0, 1, 2, 3, 4, 5, 6, 7), pf, o1); }
}

constexpr int MLA_KROW = 208, MLA_VROW = ATT_VROW;
constexpr int MLA_KBYTES = 64 * MLA_KROW, MLA_VBYTES = 64 * MLA_VROW, MLA_STAGE = MLA_KBYTES + MLA_VBYTES;
DI void mla_unit(Frame& F, int b, int hh, int qb, Xpose& X) {
    unsigned char* ws = F.ws;
    int tid = threadIdx.x; asm volatile("" : "+v"(tid));
    const int lane = tid & 63, l31 = lane & 31, h = lane >> 5, w = __builtin_amdgcn_readfirstlane(tid >> 6);
    const bf16* QM = (const bf16*)(ws + WS_QM);
    LAS unsigned char* lds = F.lds;
    const size_t rb = (size_t)b * SEQ;
    const int NT = 4 * (qb + 1), tdiag = 4 * qb + (w >> 1);
    const char* src[3]; unsigned stride[3], dst[3];
#pragma unroll
    for (int i = 0; i < 3; ++i) {
        int j = w + 8 * i; if (j >= 22) j -= 8;
        const char* p; unsigned st;
        if (j < 13) { const int byte = 1024 * j + 16 * lane, row = byte / MLA_KROW, cc = (byte % MLA_KROW) >> 4;
            if (cc >= 8 && cc < 12) { p = (const char*)(ws + WS_KPE) + ((rb + row) * 32 + (cc - 8) * 8) * 2; st = 64 * 32 * 2; }
            else { p = (const char*)(ws + WS_KVM) + ((rb + row) * 1024 + hh * 128 + (cc < 8 ? cc : 0) * 8) * 2; st = 64 * 1024 * 2; } }
        else { const int byte = 1024 * (j - 13) + 16 * lane, row = byte / MLA_VROW, cc = (byte % MLA_VROW) >> 4;
            p = (const char*)(ws + WS_KVM) + ((rb + row) * 1024 + hh * 128 + 64 + (cc < 8 ? cc : 0) * 8) * 2; st = 64 * 1024 * 2; }
        src[i] = p; stride[i] = st; dst[i] = (unsigned)(1024 * j);
    }
#define MLA_DMA(tile_, slot_) do { _Pragma("unroll") for (int i_ = 0; i_ < 3; ++i_) \
        __builtin_amdgcn_global_load_lds((const unsigned*)(src[i_] + (size_t)(tile_) * stride[i_]), (LAS unsigned*)(lds + (slot_) * MLA_STAGE + __builtin_amdgcn_readfirstlane(dst[i_])), 16, 0, 0); } while (0)
    constexpr int NS = 4;
#pragma unroll
    for (int i = 0; i < NS - 1; ++i) MLA_DMA((i < NT ? i : NT - 1), i);
    const size_t t0 = rb + qb * 256 + w * 32;
    bf16x8 qf[6];
    { const bf16* qp = QM + (t0 + l31) * 768 + hh * 96 + 8 * h;
#pragma unroll
      for (int s = 0; s < 6; ++s) qf[s] = *(const bf16x8*)(qp + 16 * s); }
    f32x16 o0, o1;
#pragma unroll
    for (int r = 0; r < 16; ++r) { o0[r] = 0.f; o1[r] = 0.f; }
    float m = 0.f, l = 0.f; f32x16 negm; bool seen = false;
#pragma unroll
    for (int r = 0; r < 16; ++r) negm[r] = 0.f;
    const int q4 = (lane & 15) >> 2, p4 = lane & 3, blk = (lane >> 4) & 1;
    const int koff = l31 * MLA_KROW + h * 16, voff = MLA_KBYTES + (4 * h + q4) * MLA_VROW + (16 * blk + 4 * p4) * 2;
    asm volatile("s_waitcnt vmcnt(0)" : "+v"(qf[0]), "+v"(qf[1]), "+v"(qf[2]), "+v"(qf[3]), "+v"(qf[4]), "+v"(qf[5]) :: "memory");
    __builtin_amdgcn_s_barrier(); asm volatile("" ::: "memory");
    int slot = 0;
    bf16x8 pka[2], pkb[2];
#define MLA_KPF(base_) do { const unsigned ka_ = (unsigned)(size_t)(lds + (base_) + koff); _Pragma("unroll") for (int q_ = 0; q_ < 2; ++q_) { \
        asm volatile("ds_read_b128 %0, %1 offset:%2" : "=v"(pka[q_]) : "v"(ka_), "i"(q_ * 32) : "memory"); \
        asm volatile("ds_read_b128 %0, %1 offset:%2" : "=v"(pkb[q_]) : "v"(ka_), "i"(32 * MLA_KROW + q_ * 32) : "memory"); } } while (0)
#define MLA_KPF_TIE "+v"(pka[0]), "+v"(pka[1]), "+v"(pkb[0]), "+v"(pkb[1])
    MLA_KPF(0);
    asm volatile("s_waitcnt lgkmcnt(0)" : MLA_KPF_TIE :: "memory");
    if (w >= 4) __builtin_amdgcn_s_setprio(1);
    for (int t = 0; t < NT; ++t) {
        const int cb = slot * MLA_STAGE;
        xpose_step<10>(F, X);
        { int s2 = slot + NS - 1; s2 = s2 >= NS ? s2 - NS : s2; const int tn = (t + NS - 1 < NT) ? t + NS - 1 : t; MLA_DMA(tn, s2); }
        if (t <= tdiag) {
            f32x16 s0, s1;
            const unsigned kaddr = (unsigned)(size_t)(lds + cb + koff);
            {
                bf16x8 ka[4], kb[4];
#pragma unroll
                for (int q = 0; q < 4; ++q) { asm volatile("ds_read_b128 %0, %1 offset:%2" : "=v"(ka[q]) : "v"(kaddr), "i"((q + 2) * 32) : "memory");
                                              asm volatile("ds_read_b128 %0, %1 offset:%2" : "=v"(kb[q]) : "v"(kaddr), "i"(32 * MLA_KROW + (q + 2) * 32) : "memory"); }
                s0 = MFMA32(pka[0], qf[0], negm); s1 = MFMA32(pkb[0], qf[0], negm);
                s0 = MFMA32(pka[1], qf[1], s0); s1 = MFMA32(pkb[1], qf[1], s1);
                __builtin_amdgcn_sched_barrier(0);
                asm volatile("s_waitcnt lgkmcnt(4)" : "+v"(ka[0]), "+v"(kb[0]), "+v"(ka[1]), "+v"(kb[1]) :: "memory");
                s0 = MFMA32(ka[0], qf[2], s0); s1 = MFMA32(kb[0], qf[2], s1);
                s0 = MFMA32(ka[1], qf[3], s0); s1 = MFMA32(kb[1], qf[3], s1);
                __builtin_amdgcn_sched_barrier(0);
                asm volatile("s_waitcnt lgkmcnt(0)" : "+v"(ka[2]), "+v"(kb[2]), "+v"(ka[3]), "+v"(kb[3]) :: "memory");
                s0 = MFMA32(ka[2], qf[4], s0); s1 = MFMA32(kb[2], qf[4], s1);
                s0 = MFMA32(ka[3], qf[5], s0); s1 = MFMA32(kb[3], qf[5], s1);
            }
            if (t == tdiag) {
                if (w & 1) {
#pragma unroll
                    for (int r = 0; r < 16; ++r) if (crow(r, h) > l31) s1[r] = NEG;
                } else {
#pragma unroll
                    for (int r = 0; r < 16; ++r) { if (crow(r, h) > l31) s0[r] = NEG; s1[r] = NEG; }
                }
            }
            softmax_pv64(s0, s1, m, negm, seen, l, o0, o1, (unsigned)(size_t)(lds + cb + voff));
        }
        if (t + 1 <= tdiag) { int sn = slot + 1; sn = sn == NS ? 0 : sn; MLA_KPF(sn * MLA_STAGE); }
        asm volatile("s_waitcnt vmcnt(3) lgkmcnt(0)" : MLA_KPF_TIE :: "memory");
        __builtin_amdgcn_s_barrier(); asm volatile("" ::: "memory");
        slot = slot == NS - 1 ? 0 : slot + 1;
    }
    __builtin_amdgcn_s_setprio(0);
    asm volatile("s_waitcnt vmcnt(0)" ::: "memory");
#undef MLA_DMA
#undef MLA_KPF
#undef MLA_KPF_TIE
    const float lt = l + __shfl_xor(l, 32); const float inv = 1.0f / lt;
    float ssq = 0.f;
#pragma unroll
    for (int r = 0; r < 16; ++r) { o0[r] *= inv; o1[r] *= inv; ssq += o0[r] * o0[r] + o1[r] * o1[r]; }
    ssq += __shfl_xor(ssq, 32);
    bf16* yp = (bf16*)(ws + WS_Y) + (t0 + l31) * 1024 + 512 + hh * 64;
    store_tile_bf16(yp, o0, h); store_tile_bf16(yp + 32, o1, h);
    if (h == 0) ((float*)(ws + WS_SSQO))[(t0 + l31) * 16 + 8 + hh] = ssq;
}
DI void mla_phase(Frame& F, Xpose& X) {
    const int G = gridDim.x, c = blockIdx.x;
    if (G == 256) {
        const int xcd = c & 7, slot = c >> 3, p = slot >> 3, j = slot & 7;
        for (int r = 0; r < 4; ++r) { const int bh = r * 32 + xcd * 4 + p; mla_unit(F, bh >> 3, bh & 7, 15 - j, X); mla_unit(F, bh >> 3, bh & 7, j, X); }
    } else {
        for (int u = c; u < NBATCH * 8 * 16; u += G) mla_unit(F, (u >> 4) >> 3, (u >> 4) & 7, 15 - (u & 15), X);
    }
}

constexpr int SWA_KROW = 144, SWA_KBYTES = 64 * SWA_KROW, SWA_STAGE = SWA_KBYTES + 64 * ATT_VROW;
DI void swa_unit(Frame& F, int b, int hh, int pt, int res, int qb) {
    unsigned char* ws = F.ws;
    int tid = threadIdx.x; asm volatile("" : "+v"(tid));
    const int lane = tid & 63, l31 = lane & 31, h = lane >> 5, w = __builtin_amdgcn_readfirstlane(tid >> 6);
    LAS unsigned char* lds = F.lds;
    const int dsh = 2 * pt;
    const size_t tb = (size_t)b * SEQ + res;
    const int j0 = qb * 256, qlo = j0 + 32 * w;
    const int tlo = j0 >= 128 ? (j0 - 128) >> 6 : 0, NT = ((j0 + 255) >> 6) - tlo + 1;
    int wfirst = (qlo - 128) >> 6; wfirst = wfirst < tlo ? tlo : wfirst; const int wlast = (qlo + 31) >> 6;
    const char* src[3]; unsigned dst[3];
    const size_t tstride = ((size_t)64 << dsh) * 512 * 2;
#pragma unroll
    for (int i = 0; i < 3; ++i) {
        int j = w + 8 * i; if (j >= 18) j -= 8;
        const int jj = j < 9 ? j : j - 9, byte = 1024 * jj + 16 * lane, row = byte / SWA_KROW; int cc = (byte % SWA_KROW) >> 4; cc = cc < 8 ? cc : 0;
        src[i] = (const char*)(ws + (j < 9 ? WS_KD : WS_VD)) + ((tb + ((size_t)(tlo * 64 + row) << dsh)) * 512 + hh * 64 + cc * 8) * 2; dst[i] = (unsigned)(1024 * j);
    }
#define SWA_DMA(tile_, slot_) do { _Pragma("unroll") for (int i_ = 0; i_ < 3; ++i_) \
        __builtin_amdgcn_global_load_lds((const unsigned*)(src[i_] + (size_t)(tile_) * tstride), (LAS unsigned*)(lds + (slot_) * SWA_STAGE + __builtin_amdgcn_readfirstlane(dst[i_])), 16, 0, 0); } while (0)
    SWA_DMA(0, 0); SWA_DMA(1, 1);
    const size_t tq = tb + ((size_t)(qlo + l31) << dsh);
    bf16x8 qf[4];
    { const bf16* qp = (const bf16*)(ws + WS_QD) + tq * 512 + hh * 64 + 8 * h;
#pragma unroll
      for (int s_ = 0; s_ < 4; ++s_) qf[s_] = *(const bf16x8*)(qp + 16 * s_); }
    f32x16 o0, o1;
#pragma unroll
    for (int r = 0; r < 16; ++r) { o0[r] = 0.f; o1[r] = 0.f; }
    float m = 0.f, l = 0.f; f32x16 negm; bool seen = false;
#pragma unroll
    for (int r = 0; r < 16; ++r) negm[r] = 0.f;
    const int q4 = (lane & 15) >> 2, p4 = lane & 3, blk = (lane >> 4) & 1;
    const int koff = l31 * SWA_KROW + h * 16, voff = SWA_KBYTES + (4 * h + q4) * ATT_VROW + (16 * blk + 4 * p4) * 2;
    asm volatile("s_waitcnt vmcnt(0)" : "+v"(qf[0]), "+v"(qf[1]), "+v"(qf[2]), "+v"(qf[3]) :: "memory");
    __builtin_amdgcn_s_barrier(); asm volatile("" ::: "memory");
    int slot = 0;
    for (int t = 0; t < NT; ++t) {
        const int cb = slot * SWA_STAGE, T = tlo + t;
        { int s2 = slot + 2; s2 = s2 >= 3 ? s2 - 3 : s2; const int tn = (t + 2 < NT) ? t + 2 : t; SWA_DMA(tn, s2); }
        if (T >= wfirst && T <= wlast) {
            f32x16 s0, s1;
            const unsigned kaddr = (unsigned)(size_t)(lds + cb + koff);
            {
                bf16x8 k0[4], k1[4];
#pragma unroll
                for (int ks = 0; ks < 4; ++ks) {
                    asm volatile("ds_read_b128 %0, %1 offset:%2" : "=v"(k0[ks]) : "v"(kaddr), "i"(ks * 32) : "memory");
                    asm volatile("ds_read_b128 %0, %1 offset:%2" : "=v"(k1[ks]) : "v"(kaddr), "i"(32 * SWA_KROW + ks * 32) : "memory"); }
                asm volatile("s_waitcnt lgkmcnt(0)" : "+v"(k0[0]), "+v"(k0[1]), "+v"(k0[2]), "+v"(k0[3]), "+v"(k1[0]), "+v"(k1[1]), "+v"(k1[2]), "+v"(k1[3]) :: "memory");
#pragma unroll
                for (int ks = 0; ks < 4; ++ks) {
                    if (ks == 0) { s0 = MFMA32(k0[0], qf[0], negm); s1 = MFMA32(k1[0], qf[0], negm); }
                    else { s0 = MFMA32(k0[ks], qf[ks], s0); s1 = MFMA32(k1[ks], qf[ks], s1); } }
            }
            if (T == wfirst || T == wlast) {
                const int dq = qlo + l31 - 64 * T;
#pragma unroll
                for (int r = 0; r < 16; ++r) { const int k0_ = crow(r, h), k1_ = 32 + crow(r, h);
                    if (k0_ > dq || k0_ < dq - 128) s0[r] = NEG;
                    if (k1_ > dq || k1_ < dq - 128) s1[r] = NEG; }
            }
            softmax_pv64(s0, s1, m, negm, seen, l, o0, o1, (unsigned)(size_t)(lds + cb + voff));
        }
        asm volatile("s_waitcnt vmcnt(3) lgkmcnt(0)" ::: "memory");
        __builtin_amdgcn_s_barrier(); asm volatile("" ::: "memory");
        slot = slot == 2 ? 0 : slot + 1;
    }
    asm volatile("s_waitcnt vmcnt(0)" ::: "memory");
#undef SWA_DMA
    const float lt = l + __shfl_xor(l, 32); const float inv = 1.0f / lt;
#pragma unroll
    for (int r = 0; r < 16; ++r) { o0[r] *= inv; o1[r] *= inv; }
    bf16* op = (bf16*)((unsigned char*)F.out + DO_ODP) + ((size_t)pt * T + tq) * 512 + hh * 64;
    store_tile_bf16(op, o0, h); store_tile_bf16(op + 32, o1, h);
    if (h == 0) { f32x2 ml = {m, lt}; *(f32x2*)((float*)((unsigned char*)F.out + DO_MLP) + (((size_t)pt * T + tq) * 8 + hh) * 2) = ml; }
}
constexpr int SWS_TILE = SWA_STAGE, SWS_STAGE = 2 * SWS_TILE;
struct SwaUnit { size_t tb; int j0, dsh, hh, pt; };
DI SwaUnit swa_decode(int u) {
    SwaUnit r; const int bh = u / 48, rem = u % 48; r.pt = rem >> 4; const int g = rem & 15, nblk = 16 >> (2 * r.pt);
    r.dsh = 2 * r.pt; r.hh = bh & 7; r.tb = (size_t)(bh >> 3) * SEQ + g / nblk; r.j0 = (g % nblk) * 256; return r;
}
DI int swa_uidx(int c, int n, int G) {
    if (G != 256) return c + n * G;
    const int xcd = c & 7, slot = c >> 3, r = n / 3, i = n - 3 * r, q = slot * 3 + i;
    return (xcd * 16 + 2 * r + (q >= 48 ? 1 : 0)) * 48 + (q >= 48 ? q - 48 : q);
}
DI void swa_stream(Frame& F) {
    unsigned char* ws = F.ws;
    int tid = threadIdx.x; asm volatile("" : "+v"(tid));
    const int lane = tid & 63, l31 = lane & 31, h = lane >> 5, w = __builtin_amdgcn_readfirstlane(tid >> 6), p8 = w >> 1;
    LAS unsigned char* lds = F.lds;
    const int G = gridDim.x, c = blockIdx.x;
    const int NUT = NBATCH * 8 * 48, NU = (NUT - c + G - 1) / G;
    if (NU <= 0) return;
    int prow[5], pcc[5]; unsigned pdst[5]; bool pv[5], pback[5];
#pragma unroll
    for (int i = 0; i < 5; ++i) { int j = w + 8 * i; if (j >= 36) j -= 8; pback[i] = j >= 18; const int jj = j % 18; pv[i] = jj >= 9;
        const int byte = 1024 * (jj % 9) + 16 * lane; prow[i] = byte / SWA_KROW; const int cc = (byte % SWA_KROW) >> 4; pcc[i] = cc < 8 ? cc : 0; pdst[i] = (unsigned)(1024 * j); }
    SwaUnit fu = swa_decode(swa_uidx(c, 0, G)), bu = fu;
#define SWS_DMA(g_, slot_) do { const int a_ = (g_) / 3, r_ = (g_) - 3 * a_; \
        if (r_ == 0 && a_ > 0) { bu = fu; fu = swa_decode(swa_uidx(c, (a_ < NU ? a_ : NU - 1), G)); } \
        _Pragma("unroll") for (int i_ = 0; i_ < 5; ++i_) { const bool bk_ = pback[i_]; \
            int pos_ = (bk_ ? bu.j0 : fu.j0) - 128 + 64 * (bk_ ? r_ + 3 : r_) + prow[i_]; pos_ = pos_ < 0 ? 0 : pos_; \
            const char* src_ = (const char*)(ws + (pv[i_] ? WS_VD : WS_KD)) + (((bk_ ? bu.tb : fu.tb) + ((size_t)pos_ << (bk_ ? bu.dsh : fu.dsh))) * 512 + (bk_ ? bu.hh : fu.hh) * 64 + pcc[i_] * 8) * 2; \
            __builtin_amdgcn_global_load_lds((const unsigned*)src_, (LAS unsigned*)(lds + (slot_) * SWS_STAGE + __builtin_amdgcn_readfirstlane(pdst[i_])), 16, 0, 0); } } while (0)
    const int q4 = (lane & 15) >> 2, p4 = lane & 3, blk = (lane >> 4) & 1;
    const int koff = l31 * SWA_KROW + h * 16, voff = SWA_KBYTES + (4 * h + q4) * ATT_VROW + (16 * blk + 4 * p4) * 2;
    bf16x8 qf[4], qfn[4];
    { const SwaUnit u0 = swa_decode(swa_uidx(c, 0, G)); const bf16* qp = (const bf16*)(ws + WS_QD) + (u0.tb + ((size_t)(u0.j0 + 32 * w + l31) << u0.dsh)) * 512 + u0.hh * 64 + 8 * h;
#pragma unroll
      for (int s_ = 0; s_ < 4; ++s_) asm volatile("global_load_dwordx4 %0, %1, off offset:%2" : "=v"(qfn[s_]) : "v"(qp), "i"(32 * s_) : "memory"); }
    SWS_DMA(0, 0); SWS_DMA(1, 1);
    asm volatile("s_waitcnt vmcnt(5)" : "+v"(qfn[0]), "+v"(qfn[1]), "+v"(qfn[2]), "+v"(qfn[3]) :: "memory");
    __builtin_amdgcn_s_barrier(); asm volatile("" ::: "memory");
    f32x16 o0, o1, negm; float m = 0.f, l = 0.f; bool seen = false;
#pragma unroll
    for (int r = 0; r < 16; ++r) { o0[r] = 0.f; o1[r] = 0.f; negm[r] = 0.f; }
#pragma unroll
    for (int s_ = 0; s_ < 4; ++s_) qf[s_] = qfn[s_];
    SwaUnit cu = swa_decode(swa_uidx(c, 0, G));
    const int NSTEP = 3 * NU + 3;
    int slot = 0;
    if (w >= 4) __builtin_amdgcn_s_setprio(1);
    for (int g = 0; g < NSTEP; ++g) {
        const int cb = slot * SWS_STAGE;
        const int q = g - p8;
        if (q >= 0 && q < 3 * NU) { const int n = q / 3, r = q - 3 * n;
            if (r == 1 && n + 1 < NU) {
                const SwaUnit nu = swa_decode(swa_uidx(c, n + 1, G)); const bf16* qp = (const bf16*)(ws + WS_QD) + (nu.tb + ((size_t)(nu.j0 + 32 * w + l31) << nu.dsh)) * 512 + nu.hh * 64 + 8 * h;
#pragma unroll
                for (int s_ = 0; s_ < 4; ++s_) asm volatile("global_load_dwordx4 %0, %1, off offset:%2" : "=v"(qfn[s_]) : "v"(qp), "i"(32 * s_) : "memory");
            } }
        { int s2 = slot + 2; s2 = s2 >= 3 ? s2 - 3 : s2; const int gn = g + 2 < NSTEP ? g + 2 : g; SWS_DMA(gn, s2); }
        if (q >= 0 && q < 3 * NU) {
            const int n = q / 3, r = q - 3 * n, ti = p8 + r;
            if (r == 0) {
                cu = swa_decode(swa_uidx(c, n, G));
#pragma unroll
                for (int s_ = 0; s_ < 4; ++s_) qf[s_] = qfn[s_];
#pragma unroll
                for (int rr = 0; rr < 16; ++rr) { o0[rr] = 0.f; o1[rr] = 0.f; negm[rr] = 0.f; }
                m = 0.f; l = 0.f; seen = false;
            }
            const int tbase = cb + (ti >= 3 ? SWS_TILE : 0);
            f32x16 s0, s1;
            const unsigned kaddr = (unsigned)(size_t)(lds + tbase + koff);
            {
                bf16x8 k0[4], k1[4];
#pragma unroll
                for (int ks = 0; ks < 4; ++ks) {
                    asm volatile("ds_read_b128 %0, %1 offset:%2" : "=v"(k0[ks]) : "v"(kaddr), "i"(ks * 32) : "memory");
                    asm volatile("ds_read_b128 %0, %1 offset:%2" : "=v"(k1[ks]) : "v"(kaddr), "i"(32 * SWA_KROW + ks * 32) : "memory"); }
                asm volatile("s_waitcnt lgkmcnt(0)" : "+v"(k0[0]), "+v"(k0[1]), "+v"(k0[2]), "+v"(k0[3]), "+v"(k1[0]), "+v"(k1[1]), "+v"(k1[2]), "+v"(k1[3]) :: "memory");
#pragma unroll
                for (int ks = 0; ks < 4; ++ks) {
                    if (ks == 0) { s0 = MFMA32(k0[0], qf[0], negm); s1 = MFMA32(k1[0], qf[0], negm); }
                    else { s0 = MFMA32(k0[ks], qf[ks], s0); s1 = MFMA32(k1[ks], qf[ks], s1); } }
            }
            if (r != 1 || cu.j0 == 0) {
                const int dq = 32 * w + l31 + 128 - 64 * ti;
                int lo = dq - 128; const int kmin = 128 - cu.j0 - 64 * ti; lo = lo > kmin ? lo : kmin;
                if (r == 2) {
#pragma unroll
                    for (int rr = 0; rr < 16; ++rr) { if (crow(rr, h) > dq) s0[rr] = NEG; if (32 + crow(rr, h) > dq) s1[rr] = NEG; }
                } else {
#pragma unroll
                    for (int rr = 0; rr < 16; ++rr) { if (crow(rr, h) < lo) s0[rr] = NEG; if (32 + crow(rr, h) < lo) s1[rr] = NEG; }
                }
            }
            softmax_pv64(s0, s1, m, negm, seen, l, o0, o1, (unsigned)(size_t)(lds + tbase + voff));
            if (r == 2) {
                const float lt = l + __shfl_xor(l, 32); const float inv = 1.0f / lt;
#pragma unroll
                for (int rr = 0; rr < 16; ++rr) { o0[rr] *= inv; o1[rr] *= inv; }
                const size_t tq = cu.tb + ((size_t)(cu.j0 + 32 * w + l31) << cu.dsh);
                bf16* op = (bf16*)((unsigned char*)F.out + DO_ODP) + ((size_t)cu.pt * T + tq) * 512 + cu.hh * 64;
                store_tile_bf16(op, o0, h); store_tile_bf16(op + 32, o1, h);
                if (h == 0) { f32x2 ml = {m, lt}; *(f32x2*)((float*)((unsigned char*)F.out + DO_MLP) + (((size_t)cu.pt * T + tq) * 8 + cu.hh) * 2) = ml; }
            }
        }
        asm volatile("" ::: "memory");
        asm volatile("s_waitcnt vmcnt(5) lgkmcnt(0)" : "+v"(qfn[0]), "+v"(qfn[1]), "+v"(qfn[2]), "+v"(qfn[3]) :: "memory");
        __builtin_amdgcn_s_barrier(); asm volatile("" ::: "memory");
        slot = slot == 2 ? 0 : slot + 1;
    }
    __builtin_amdgcn_s_setprio(0);
    asm volatile("s_waitcnt vmcnt(0)" ::: "memory");
#undef SWS_DMA
}

DI void swa_phase(Frame& F) {
    for (int u = blockIdx.x; u < NBATCH * 8 * 48; u += gridDim.x) {
        const int bh = u / 48, rem = u % 48, pt = rem >> 4, g = rem & 15;
        const int nblk = 16 >> (2 * pt);
        swa_unit(F, bh >> 3, bh & 7, pt, g / nblk, g % nblk);
    }
}

DI void dil_phase(Frame& F) {
    unsigned char* ws = F.ws;
    const int h = (((int)threadIdx.x >> 5) & 1), l31 = ((int)threadIdx.x & 31), lane = ((int)threadIdx.x & 63);
    LAS unsigned char* vl = F.lds + LDS_WSCR + F.wave * 16384;
    {
    const bf16* QD = (const bf16*)(ws + WS_QD); const bf16* KD = (const bf16*)(ws + WS_KD); const bf16* VD = (const bf16*)(ws + WS_VD);
    bf16* ODP = (bf16*)((unsigned char*)F.out + DO_ODP); float* MLP = (float*)((unsigned char*)F.out + DO_MLP);
    constexpr int NTASK = NBATCH * 8 * 3 * 128;
#define DIL_DECODE(task_, tb_, j0_, dsh_, hh_, pt_) do { const int g_ = (task_) & 127; pt_ = ((task_) >> 7) % 3; const int bh_ = (task_) / 384; hh_ = bh_ & 7; dsh_ = 2 * pt_; \
        const int gpr_ = (SEQ >> dsh_) >> 5; const int res_ = g_ / gpr_; j0_ = (g_ % gpr_) * 32; tb_ = (size_t)(bh_ >> 3) * SEQ + res_; } while (0)
#define DIL_LOADQ(dst_, tb_, j0_, dsh_, hh_) do { const bf16* qp_ = QD + (tb_ + ((size_t)((j0_) + l31) << (dsh_))) * 512 + (hh_) * 64 + 8 * h; \
        _Pragma("unroll") for (int s_ = 0; s_ < 4; ++s_) dst_[s_] = *(const bf16x8*)(qp_ + 16 * s_); } while (0)
#define DIL_LOADKV(kd_, vd_, tb_, j0_, dsh_, hh_, kt_) do { const int pb_ = (j0_) + 32 * (kt_); \
        { int pos_ = pb_ + l31; pos_ = pos_ < 0 ? 0 : pos_; const bf16* kp_ = KD + (tb_ + ((size_t)pos_ << (dsh_))) * 512 + (hh_) * 64 + 8 * h; \
          _Pragma("unroll") for (int s_ = 0; s_ < 4; ++s_) kd_[s_] = *(const bf16x8*)(kp_ + 16 * s_); } \
        _Pragma("unroll") for (int i_ = 0; i_ < 4; ++i_) { const int c_ = lane + 64 * i_; int pos_ = pb_ + (c_ >> 3); pos_ = pos_ < 0 ? 0 : pos_; \
          vd_[i_] = *(const u32x4*)(VD + (tb_ + ((size_t)pos_ << (dsh_))) * 512 + (hh_) * 64 + (c_ & 7) * 8); } } while (0)
    int task = F.gw;
    if (task < NTASK) {
        size_t tb, ntb = 0; int j0, dsh, hh, pt, nj0 = 0, ndsh = 0, nhh = 0, npt = 0;
        DIL_DECODE(task, tb, j0, dsh, hh, pt);
        int kt = -(j0 >> 5); kt = kt < -4 ? -4 : kt;
        bf16x8 qf[4], qfn[4], kf[4], kfn[4]; u32x4 vv[4], vvn[4];
        DIL_LOADQ(qf, tb, j0, dsh, hh);
#pragma unroll
        for (int s_ = 0; s_ < 4; ++s_) qfn[s_] = qf[s_];
        DIL_LOADKV(kfn, vvn, tb, j0, dsh, hh, kt);
        f32x16 o0, o1;
#pragma unroll
        for (int r = 0; r < 16; ++r) { o0[r] = 0.f; o1[r] = 0.f; }
        float m = NEG, l = 0.f;
        for (;;) {
#pragma unroll
            for (int i = 0; i < 4; ++i) { kf[i] = kfn[i]; vv[i] = vvn[i]; }
#pragma unroll
            for (int i = 0; i < 4; ++i) { const int c = lane + 64 * i; *(LAS u32x4*)(vl + (c >> 3) * 144 + (c & 7) * 16) = vv[i]; }
            const bool last_tile = (kt == 0);
            int nkt = kt + 1, ntask = task; bool has_next = true;
            if (last_tile) {
                ntask = task + F.ngw; has_next = ntask < NTASK;
                if (has_next) { DIL_DECODE(ntask, ntb, nj0, ndsh, nhh, npt); nkt = -(nj0 >> 5); nkt = nkt < -4 ? -4 : nkt; DIL_LOADQ(qfn, ntb, nj0, ndsh, nhh); DIL_LOADKV(kfn, vvn, ntb, nj0, ndsh, nhh, nkt); }
            } else { DIL_LOADKV(kfn, vvn, tb, j0, dsh, hh, nkt); }
            f32x16 sc;
#pragma unroll
            for (int r = 0; r < 16; ++r) sc[r] = 0.f;
#pragma unroll
            for (int ss = 0; ss < 4; ++ss) sc = MFMA32(kf[ss], qf[ss], sc);
            { const int pb = j0 + 32 * kt;
#pragma unroll
              for (int r = 0; r < 16; ++r) { const int kk = crow(r, h);
                bool ok = (pb + kk) >= 0;
                if (kt == -4) ok = ok && (kk >= l31);
                if (kt == 0) ok = ok && (kk <= l31);
                if (!ok) sc[r] = NEG; } }
            softmax_pv(sc, m, l, o0, o1, vl, lane, h);
            if (last_tile) {
                const float lt = l + __shfl_xor(l, 32); const float inv = 1.0f / lt;
#pragma unroll
                for (int r = 0; r < 16; ++r) { o0[r] *= inv; o1[r] *= inv; }
                const size_t tq = tb + ((size_t)(j0 + l31) << dsh);
                bf16* op = ODP + ((size_t)pt * T + tq) * 512 + hh * 64;
                store_tile_bf16(op, o0, h); store_tile_bf16(op + 32, o1, h);
                if (h == 0) { f32x2 ml = {m, lt}; *(f32x2*)(MLP + (((size_t)pt * T + tq) * 8 + hh) * 2) = ml; }
                if (!has_next) break;
                tb = ntb; j0 = nj0; dsh = ndsh; hh = nhh; pt = npt; task = ntask;
#pragma unroll
                for (int s_ = 0; s_ < 4; ++s_) qf[s_] = qfn[s_];
#pragma unroll
                for (int r = 0; r < 16; ++r) { o0[r] = 0.f; o1[r] = 0.f; }
                m = NEG; l = 0.f;
            }
            kt = nkt;
        }
    }
#undef DIL_DECODE
#undef DIL_LOADQ
#undef DIL_LOADKV
    }
}

DI void p3_attention(Frame& F) {
    Xpose X; X.next = F.gw; X.cur = 0; X.pend = false; X.tick = 0;
    X.w1 = in_ptr<IN_W1>(); X.w3 = in_ptr<IN_W3>(); X.w2 = in_ptr<IN_W2>(); X.s1 = in_ptr<IN_WS1>(); X.s3 = in_ptr<IN_WS3>(); X.s2 = in_ptr<IN_WS2>();
#pragma unroll
    for (int i = 0; i < 16; ++i) X.v[i] = (f32x4){0.f, 0.f, 0.f, 0.f};
    for (int rep = 0; rep < REP_MLA; ++rep) mla_phase(F, X);
    while (X.pend || X.next < XP_TILES) xpose_step<1>(F, X);
    asm volatile("s_waitcnt vmcnt(0) lgkmcnt(0)" ::: "memory"); __syncthreads();
    for (int rep = 0; rep < REP_DIL; ++rep) swa_stream(F);
}

DI void p3b_merge(Frame& F) {
    unsigned char* ws = F.ws;
    const bf16* ODP = (const bf16*)((unsigned char*)F.out + DO_ODP); const float* MLP = (const float*)((unsigned char*)F.out + DO_MLP);
    bf16* Y = (bf16*)(ws + WS_Y); const float* SSQO = (const float*)(ws + WS_SSQO);
    const int gt = blockIdx.x * 512 + ((int)threadIdx.x), ngt = gridDim.x * 512;
    for (int idx0 = gt; idx0 < T * 64; idx0 += 4 * ngt) {
        u32x4 v[4][3]; f32x2 ml[4][3]; f32x4 sa[4], sb[4];
#pragma unroll
        for (int q = 0; q < 4; ++q) { int idx = idx0 + q * ngt; idx = idx < T * 64 ? idx : idx0; const int dg = idx & 7, hh = (idx >> 3) & 7; const size_t t = (size_t)(idx >> 6);
            sa[q] = *(const f32x4*)(SSQO + t * 16 + 8); sb[q] = *(const f32x4*)(SSQO + t * 16 + 12);
#pragma unroll
            for (int p = 0; p < 3; ++p) { ml[q][p] = *(const f32x2*)(MLP + (((size_t)p * T + t) * 8 + hh) * 2); v[q][p] = *(const u32x4*)(ODP + ((size_t)p * T + t) * 512 + hh * 64 + dg * 8); } }
#pragma unroll
        for (int q = 0; q < 4; ++q) { const int idx = idx0 + q * ngt; if (idx >= T * 64) break; const int dg = idx & 7, hh = (idx >> 3) & 7; const size_t t = (size_t)(idx >> 6);
            const float M = fmaxf(ml[q][0][0], fmaxf(ml[q][1][0], ml[q][2][0]));
            float w[3], wsum = 0.f;
#pragma unroll
            for (int p = 0; p < 3; ++p) { w[p] = ml[q][p][1] * __builtin_amdgcn_exp2f(ml[q][p][0] - M); wsum += w[p]; }
            const float inv = 1.0f / wsum;
            float o[8];
#pragma unroll
            for (int i = 0; i < 8; ++i) o[i] = 0.f;
#pragma unroll
            for (int p = 0; p < 3; ++p) { const float wp = w[p] * inv; const unsigned a = v[q][p][0], b = v[q][p][1], c = v[q][p][2], d = v[q][p][3];
                o[0] += wp * __uint_as_float(a << 16); o[1] += wp * __uint_as_float(a & 0xffff0000u);
                o[2] += wp * __uint_as_float(b << 16); o[3] += wp * __uint_as_float(b & 0xffff0000u);
                o[4] += wp * __uint_as_float(c << 16); o[5] += wp * __uint_as_float(c & 0xffff0000u);
                o[6] += wp * __uint_as_float(d << 16); o[7] += wp * __uint_as_float(d & 0xffff0000u); }
            float ssq = 0.f;
#pragma unroll
            for (int i = 0; i < 8; ++i) ssq += o[i] * o[i];
            ssq = wave_sum(ssq);
            u32x4 w4; w4.x = pk2(o[0], o[1]); w4.y = pk2(o[2], o[3]); w4.z = pk2(o[4], o[5]); w4.w = pk2(o[6], o[7]);
            *(u32x4*)(Y + t * 1024 + hh * 64 + dg * 8) = w4;
            if ((idx & 63) == 0) { const f32x4 a = sa[q], b = sb[q];
                const float rd = 1.0f / sqrtf(ssq * (1.0f / 512.0f) + RMS_EPS), rm = 1.0f / sqrtf((((a.x + a.y) + (a.z + a.w)) + ((b.x + b.y) + (b.z + b.w))) * (1.0f / 512.0f) + RMS_EPS);
                f32x2 r2 = {rd / rm, rm}; *(f32x2*)((float*)(ws + WS_RDRM) + t * 2) = r2; }
        }
    }
}

DI void ln1_row(const float* xr, const bf16* mr, bf16* dstb, const float* g, const float* b, int lane) {
    f32x4 v[4]; float s = 0.f;
#pragma unroll
    for (int j = 0; j < 4; ++j) { const f32x4 xv = *(const f32x4*)(xr + 4 * lane + 256 * j); const u32x2 mv = *(const u32x2*)(mr + 4 * lane + 256 * j);
        v[j].x = ALPHA * xv.x + __uint_as_float(mv[0] << 16); v[j].y = ALPHA * xv.y + __uint_as_float(mv[0] & 0xffff0000u);
        v[j].z = ALPHA * xv.z + __uint_as_float(mv[1] << 16); v[j].w = ALPHA * xv.w + __uint_as_float(mv[1] & 0xffff0000u);
        s += (v[j].x + v[j].y) + (v[j].z + v[j].w); }
    const float mean = wave_sum(s) * (1.f / 1024.f); float s2 = 0.f;
#pragma unroll
    for (int j = 0; j < 4; ++j) { v[j] = v[j] - mean; s2 += (v[j].x * v[j].x + v[j].y * v[j].y) + (v[j].z * v[j].z + v[j].w * v[j].w); }
    const float rstd = 1.f / sqrtf(wave_sum(s2) * (1.f / 1024.f) + LN_EPS);
#pragma unroll
    for (int j = 0; j < 4; ++j) { const f32x4 gg = *(const f32x4*)(g + 4 * lane + 256 * j), bb = *(const f32x4*)(b + 4 * lane + 256 * j);
        f32x4 o = v[j] * rstd * gg + bb;
        u32x2 w; w.x = pk2(o.x, o.y); w.y = pk2(o.z, o.w); *(u32x2*)(dstb + 4 * lane + 256 * j) = w; }
}
DI void p5a_rows(Frame& F, int row0) {
    bf16* H1B = (bf16*)F.out; const bf16* MIXB = (const bf16*)(F.ws + WS_MIXB); const float* g1 = in_ptr<IN_LN1G>(); const float* b1 = in_ptr<IN_LN1B>(); const float* x = in_ptr<IN_X>();
    for (int row = row0 + F.wave; row < row0 + 256; row += 8) ln1_row(x + (size_t)row * 1024, MIXB + (size_t)row * 1024, H1B + (size_t)row * H1_LD, g1, b1, ((int)threadIdx.x & 63));
}
DI void p5a_ln1(Frame& F) {
    bf16* H1B = (bf16*)F.out; const bf16* MIXB = (const bf16*)(F.ws + WS_MIXB); const float* g1 = in_ptr<IN_LN1G>(); const float* b1 = in_ptr<IN_LN1B>(); const float* x = in_ptr<IN_X>();
    for (int row = F.gw; row < T; row += F.ngw) ln1_row(x + (size_t)row * 1024, MIXB + (size_t)row * 1024, H1B + (size_t)row * H1_LD, g1, b1, ((int)threadIdx.x & 63));
}
DI void wg_handoff() { asm volatile("s_waitcnt vmcnt(0)" ::: "memory"); __syncthreads(); __builtin_amdgcn_fence(__ATOMIC_ACQUIRE, "agent"); asm volatile("s_waitcnt vmcnt(0)" ::: "memory"); __syncthreads(); }
DI void p5_chain(Frame& F) {
    DenseSched S; S.init(T, 256, 1024, (const bf16*)(F.ws + WS_W_R), gridDim.x, blockIdx.x);
    pg::Unit u; if (!S.next(0, u)) return;
    const int blk = u.pm;
    p5a_rows(F, blk * 256);
    wg_handoff();
    { EpiRouter E{(float*)(F.ws + WS_LOGITS)}; pg::gemm_phase<EpiRouter, DenseSched>(F.lds, (const char*)F.out, H1_LD, 1024, S, E); }
    wg_handoff();
    p5c_route(F, blk * 256, blk * 256 + 256, 128);
}
DI f32x4 bf4(const u32x2 v) { f32x4 r; r.x = __uint_as_float(v[0] << 16); r.y = __uint_as_float(v[0] & 0xffff0000u); r.z = __uint_as_float(v[1] << 16); r.w = __uint_as_float(v[1] & 0xffff0000u); return r; }
DI void p9_combine(Frame& F) {
    unsigned char* ws = F.ws;
    const unsigned char* Y2 = (const unsigned char*)(ws + WS_Y2C); const unsigned* POSC = (const unsigned*)(ws + WS_RANK); const bf16* SHB = (const bf16*)F.out + 1024; const float* g2 = in_ptr<IN_LN2G>(); const float* b2 = in_ptr<IN_LN2B>();
    const int lane = ((int)threadIdx.x & 63);
    u32x4 pa = {0u, 0u, 0u, 0u}, pb = {0u, 0u, 0u, 0u};
    if (F.gw < T) { pa = *(const u32x4*)(POSC + (size_t)F.gw * 8); pb = *(const u32x4*)(POSC + (size_t)F.gw * 8 + 4); }
    for (int row = F.gw; row < T; row += F.ngw) {
        u32x4 na = pa, nb = pb;
        { const int nrow = row + F.ngw < T ? row + F.ngw : row; na = *(const u32x4*)(POSC + (size_t)nrow * 8); nb = *(const u32x4*)(POSC + (size_t)nrow * 8 + 4); }
        u32x4 v[8];
#pragma unroll
        for (int k = 0; k < 8; ++k) v[k] = *(const u32x4*)(Y2 + (size_t)(k < 4 ? pa[k] : pb[k - 4]) * 1024 + 16 * lane);
        float* zr = F.out + (size_t)row * 1024 + 16 * lane; const bf16* sr = SHB + (size_t)row * H1_LD + 16 * lane;
        const u32x4 sh0 = *(const u32x4*)sr, sh1 = *(const u32x4*)(sr + 8);
        f32x4 x[4];
        { const bf16* hr = (const bf16*)F.out + (size_t)row * H1_LD + 16 * lane; const u32x4 h0 = *(const u32x4*)hr, h1v = *(const u32x4*)(hr + 8);
          u32x2 t0, t1, t2, t3; t0[0] = h0[0]; t0[1] = h0[1]; t1[0] = h0[2]; t1[1] = h0[3]; t2[0] = h1v[0]; t2[1] = h1v[1]; t3[0] = h1v[2]; t3[1] = h1v[3];
          x[0] = bf4(t0); x[1] = bf4(t1); x[2] = bf4(t2); x[3] = bf4(t3); }
        f32x4 s[4];
#pragma unroll
        for (int j = 0; j < 4; ++j) s[j] = (f32x4){0.f, 0.f, 0.f, 0.f};
#pragma unroll
        for (int k = 0; k < 8; ++k)
#pragma unroll
            for (int j = 0; j < 4; ++j) { const f32x2 a = __builtin_amdgcn_cvt_pk_f32_fp8((int)v[k][j], false), b = __builtin_amdgcn_cvt_pk_f32_fp8((int)v[k][j], true);
                s[j].x += a[0]; s[j].y += a[1]; s[j].z += b[0]; s[j].w += b[1]; }
        { u32x2 t0, t1, t2, t3; t0[0] = sh0[0]; t0[1] = sh0[1]; t1[0] = sh0[2]; t1[1] = sh0[3]; t2[0] = sh1[0]; t2[1] = sh1[1]; t3[0] = sh1[2]; t3[1] = sh1[3];
          x[0] = x[0] * ALPHA + s[0] * (1.0f / Y2_SCALE) + bf4(t0); x[1] = x[1] * ALPHA + s[1] * (1.0f / Y2_SCALE) + bf4(t1);
          x[2] = x[2] * ALPHA + s[2] * (1.0f / Y2_SCALE) + bf4(t2); x[3] = x[3] * ALPHA + s[3] * (1.0f / Y2_SCALE) + bf4(t3); }
        float sm = 0.f;
#pragma unroll
        for (int j = 0; j < 4; ++j) sm += (x[j].x + x[j].y) + (x[j].z + x[j].w);
        const float mean = wave_sum(sm) * (1.f / 1024.f); float s2 = 0.f;
#pragma unroll
        for (int j = 0; j < 4; ++j) { x[j] = x[j] - mean; s2 += (x[j].x * x[j].x + x[j].y * x[j].y) + (x[j].z * x[j].z + x[j].w * x[j].w); }
        const float rstd = 1.f / sqrtf(wave_sum(s2) * (1.f / 1024.f) + LN_EPS);
        const float* gp = g2 + 16 * lane; const float* bp = b2 + 16 * lane;
#pragma unroll
        for (int j = 0; j < 4; ++j) *(f32x4*)(zr + 4 * j) = x[j] * rstd * *(const f32x4*)(gp + 4 * j) + *(const f32x4*)(bp + 4 * j);
        pa = na; pb = nb;
    }
}

struct Args { const float* in[21]; float* out; unsigned char* ws; int ph_lo, ph_hi; };
constexpr int NPHASE = 13;

__global__ void __launch_bounds__(512, 2) mk_fwd(Args args) {
    extern __shared__ __attribute__((aligned(16))) unsigned char lds[];
    Frame F;
    F.lds = (LAS unsigned char*)lds;
    F.wave = __builtin_amdgcn_readfirstlane((int)threadIdx.x >> 6);
    F.gw = blockIdx.x * 8 + F.wave; F.ngw = gridDim.x * 8;
    F.out = args.out; F.ws = args.ws;
    volatile LAS unsigned* misc = (volatile LAS unsigned*)(F.lds + LDS_MISC);
    if (((int)threadIdx.x) < 4) misc[((int)threadIdx.x)] = 0u;
    __syncthreads();
    XcdBarrier bar = xcd_barrier_post((unsigned*)(F.ws + WS_CTL) + CW_BAR, misc);
    const int lo = args.ph_lo, hi = args.ph_hi;
#define IN(k) (lo <= (k) && (k) < hi)
#define SEAM(k) do { if (IN(k) && IN((k) + 1)) xcd_barrier(bar); } while (0)
    if (IN(0)) for (int rep = 0; rep < REP_P0; ++rep) p0_prologue(F);
    SEAM(0);
    if (IN(1)) for (int rep = 0; rep < REP_P1; ++rep) p1_proj(F);
    SEAM(1);
    if (IN(2)) for (int rep = 0; rep < REP_P2; ++rep) p2_up(F);
    SEAM(2);
    if (IN(3)) p3_attention(F);
    SEAM(3);
    if (IN(4)) p3b_merge(F);
    SEAM(4);
    if (IN(5)) for (int rep = 0; rep < REP_P4; ++rep) p4_wo(F);
    SEAM(5);
    const bool chain5 = (int)gridDim.x * 256 == T;
    if (IN(6)) { if (chain5) p5_chain(F); else p5a_ln1(F); }
    if (!chain5) SEAM(6);
    if (IN(7) && !chain5) p5b_router(F);
    if (!chain5) SEAM(7);
    if (IN(8) && !chain5) p5c_route(F);
    SEAM(8);
    if (IN(9)) p6_scatter(F);
    SEAM(9);
    if (IN(10)) for (int rep = 0; rep < REP_P7; ++rep) p7_gemm1(F);
    SEAM(10);
    if (IN(11)) { p8_gemm2_v2<0>(F); if (REP_P8 > 1) p8_gemm2_v2<REP_P8 - 1>(F); p8s_shared2(F); }
    SEAM(11);
    if (IN(12)) p9_combine(F);
#undef IN
#undef SEAM
}

#ifndef MK_N_LAUNCHES
#define MK_N_LAUNCHES 1
#endif

extern "C" void kernel_launch(void* const* d_in, const int* in_sizes, int n_in, void* d_out, int out_size, void* d_ws, size_t ws_size, hipStream_t stream) {
    static int grid = 0;
    if (grid == 0) {
        if (n_in != 21 || out_size != T * DM || ws_size < WS_NEED) { fprintf(stderr, "kernel_launch: unexpected shapes (n_in %d out %d ws %zu)\n", n_in, out_size, ws_size); grid = -1; return; }
        int dev = 0, cus = 0, per_cu = 0;
        if (hipGetDevice(&dev) != hipSuccess || hipDeviceGetAttribute(&cus, hipDeviceAttributeMultiprocessorCount, dev) != hipSuccess) { grid = -1; return; }
        if (hipFuncSetAttribute((const void*)mk_fwd, hipFuncAttributeMaxDynamicSharedMemorySize, LDS_BYTES) != hipSuccess) { fprintf(stderr, "kernel_launch: hipFuncSetAttribute failed\n"); grid = -1; return; }
        if (hipOccupancyMaxActiveBlocksPerMultiprocessor(&per_cu, (const void*)mk_fwd, 512, LDS_BYTES) != hipSuccess || per_cu < 1) { fprintf(stderr, "kernel_launch: occupancy query says %d\n", per_cu); }
        (void)hipGetLastError();
        grid = cus;
    }
    if (grid < 0) return;
    (void)hipMemsetAsync((char*)d_ws + WS_CTL, 0, CTL_BYTES, stream);
    Args a{};
    for (int i = 0; i < 21; ++i) a.in[i] = (const float*)d_in[i];
    a.out = (float*)d_out; a.ws = (unsigned char*)d_ws;
#if MK_N_LAUNCHES == 1
    a.ph_lo = 0; a.ph_hi = NPHASE;
    hipLaunchKernelGGL(mk_fwd, dim3(grid), dim3(512), LDS_BYTES, stream, a);
#else
    for (int p = 0; p < NPHASE; ++p) { a.ph_lo = p; a.ph_hi = p + 1; hipLaunchKernelGGL(mk_fwd, dim3(grid), dim3(512), LDS_BYTES, stream, a); }
#endif
}
```

```cpp
#include <hip/hip_runtime.h>
#include <stdint.h>
#include <stdio.h>

#define DI __device__ __forceinline__
#ifndef REP_P0
#define REP_P0 1
#endif
#ifndef REP_P1
#define REP_P1 1
#endif
#ifndef REP_P2
#define REP_P2 1
#ifndef REP_P2B
#define REP_P2B 1
#endif
#endif
#ifndef REP_MLA
#define REP_MLA 1
#endif
#ifndef REP_DIL
#define REP_DIL 1
#endif
#ifndef REP_P4
#define REP_P4 1
#endif
#ifndef REP_P7
#define REP_P7 1
#endif
#ifndef REP_P8
#define REP_P8 1
#endif
#define LAS __attribute__((address_space(3)))
typedef unsigned short bf16;
typedef short bf16x8 __attribute__((ext_vector_type(8)));
typedef short s16x4 __attribute__((ext_vector_type(4)));
typedef int i32x4 __attribute__((ext_vector_type(4)));
typedef float f32x16 __attribute__((ext_vector_type(16)));
typedef float f32x4 __attribute__((ext_vector_type(4)));
typedef float f32x2 __attribute__((ext_vector_type(2)));
typedef unsigned u32x4 __attribute__((ext_vector_type(4)));
typedef unsigned u32x2 __attribute__((ext_vector_type(2)));
typedef __bf16 bf16x2_t __attribute__((ext_vector_type(2)));

constexpr int T = 65536, DM = 1024, SEQ = 4096, NBATCH = 16;
constexpr int NE = 256, TOPK = 8, FF = 256;
constexpr int INW = 2080;
constexpr float ALPHA = 1.189207115002721f;
constexpr float LN_EPS = 1e-5f, RMS_EPS = 1e-6f;
constexpr float LOG2E = 1.4426950408889634f;
constexpr float CD2 = 0.125f * LOG2E;
constexpr float CM2 = 0.10206207261596575f * LOG2E;
constexpr float NEG = -1e30f;

constexpr size_t MiB = 1u << 20;
constexpr size_t WS_CTL = 0, CTL_BYTES = 128 * 1024;
constexpr size_t WS_ROPE_D = 1 * MiB;
constexpr size_t WS_ROPE_M = 1 * MiB + 256 * 1024;
constexpr size_t WS_W_IN_T = 2 * MiB;
constexpr size_t WS_W_UQ_T = 7 * MiB;
constexpr size_t WS_W_UKV_T = 8 * MiB;
constexpr size_t WS_W_O_T = 9 * MiB;
constexpr size_t WS_W_R = 11 * MiB;
constexpr size_t WS_WS13_T = 12 * MiB;
constexpr size_t WS_WS2_T = 13 * MiB;
constexpr size_t WS_W2_T = 16 * MiB;
constexpr size_t WS_W13_T = 144 * MiB;
constexpr size_t WS_XB = 400 * MiB;
constexpr size_t WS_Y = 400 * MiB;
constexpr size_t WS_QD = 528 * MiB, WS_KD = 592 * MiB, WS_VD = 656 * MiB;
constexpr size_t WS_CQKV = 720 * MiB;
constexpr size_t WS_KPE = 784 * MiB;
constexpr size_t WS_QM = 788 * MiB;
constexpr size_t WS_KVM = 884 * MiB;
constexpr size_t WS_SSQC = 1012 * MiB;
constexpr size_t WS_SSQO = 1016 * MiB;
constexpr size_t WS_MIXB = 528 * MiB;
constexpr int H1_LD = 2048;
constexpr size_t WS_Y2C = 144 * MiB;
constexpr size_t WS_LOGITS = 656 * MiB;
constexpr size_t WS_HB = 656 * MiB;
constexpr size_t WS_HS = 944 * MiB;
constexpr size_t WS_ROWINFO = 976 * MiB;
constexpr size_t WS_EIDX = 982 * MiB, WS_GWT = 984 * MiB, WS_RANK = 986 * MiB;
constexpr size_t WS_END = 988 * MiB;
constexpr size_t WS_RQRK = 1020 * MiB;
constexpr size_t WS_RDRM = 1021 * MiB;
constexpr size_t WS_NEED = 1022 * MiB;
constexpr int RMAX = T * TOPK + NE * 255;
constexpr size_t DO_ODP = 0, DO_MLP = 192 * MiB;
constexpr int CW_BAR = 4096;
constexpr int CW_TOTAL = 16384;

constexpr int LDS_WSCR = 0;
constexpr int LDS_TAB = 147456 - 64 - 3072;
constexpr int LDS_MISC = 147456 - 64;
constexpr int LDS_BYTES = 147456;

#define XB_TMO      128
#define XB_XCNT(j)  (256  + 64 * (j))
#define XB_XSUB(j)  (1280 + 64 * (j))
#define XB_XGEN(j)  (2304 + 64 * (j))
#define XB_TOP      3328
#define XB_TOPGEN   3392
#define XCD_BAR_WORDS 3456
#define XB_SPIN_CAP (1u << 22)

__device__ __forceinline__ unsigned xb_ld(unsigned* p)              { return __hip_atomic_load(p, __ATOMIC_RELAXED, __HIP_MEMORY_SCOPE_AGENT); }
__device__ __forceinline__ unsigned xb_add(unsigned* p, unsigned v) { return __hip_atomic_fetch_add(p, v, __ATOMIC_RELAXED, __HIP_MEMORY_SCOPE_AGENT); }
__device__ __forceinline__ unsigned xb_xcc_id() { return (unsigned)__builtin_amdgcn_s_getreg((3 << 11) | 20) & 0xFu; }
#define XB_SPIN(cond, bar) do { unsigned _sp = 0; while (cond) { __builtin_amdgcn_s_sleep(1); \
    if ((++_sp & 255u) == 0u) { if (xb_ld(&(bar)[XB_TMO])) break; if (_sp > XB_SPIN_CAP) { atomicAdd(&(bar)[XB_TMO], 1u); break; } } } } while (0)

struct XcdBarrier { unsigned* bar; unsigned x; volatile LAS unsigned* st; };

__device__ __forceinline__ XcdBarrier xcd_barrier_post(unsigned* bar, volatile LAS unsigned* st) {
    XcdBarrier b; b.bar = bar; b.x = xb_xcc_id(); b.st = st;
    if (threadIdx.x == 0) (void)xb_add(&bar[XB_XCNT(b.x)], 1u);
    return b;
}
__device__ __forceinline__ void xcd_barrier_complete(unsigned* bar, unsigned x, unsigned& nloc, unsigned& nx) {
    const unsigned G = gridDim.x * gridDim.y * gridDim.z;
    unsigned sum, cnt, mine, sp = 0u;
    for (;;) {
        sum = 0u; cnt = 0u; mine = 0u;
#pragma unroll
        for (unsigned j = 0; j < 16; ++j) { const unsigned c = xb_ld(&bar[XB_XCNT(j)]); sum += c; cnt += (c > 0u) ? 1u : 0u; mine = (j == x) ? c : mine; }
        if (sum == G) break;
        __builtin_amdgcn_s_sleep(1);
        if ((++sp & 255u) == 0u) { if (xb_ld(&bar[XB_TMO])) break; if (sp > XB_SPIN_CAP) { atomicAdd(&bar[XB_TMO], 1u); break; } }
    }
    nloc = mine > 0u ? mine : 1u; nx = cnt > 0u ? cnt : 1u;
}
__device__ __forceinline__ void xcd_barrier(const XcdBarrier& b) {
    asm volatile("s_waitcnt vmcnt(0)" ::: "memory");
    __syncthreads();
    if (threadIdx.x == 0) {
        unsigned* bar = b.bar;
        __builtin_amdgcn_s_waitcnt(0);
        unsigned nloc = b.st[0], nx = b.st[1];
        if (nloc == 0u) { xcd_barrier_complete(bar, b.x, nloc, nx); b.st[0] = nloc; b.st[1] = nx; }
        const unsigned old = xb_add(&bar[XB_XSUB(b.x)], 1u);
        const unsigned gen = old / nloc;
        if (old + 1u == (gen + 1u) * nloc) {
            __builtin_amdgcn_fence(__ATOMIC_RELEASE, "agent");
            asm volatile("s_waitcnt vmcnt(0)" ::: "memory");
            const unsigned og = xb_add(&bar[XB_TOP], 1u);
            const unsigned tg = og / nx;
            if (og + 1u == (tg + 1u) * nx) xb_add(&bar[XB_TOPGEN], 1u);
            else XB_SPIN(xb_ld(&bar[XB_TOPGEN]) == tg, bar);
            __builtin_amdgcn_fence(__ATOMIC_ACQUIRE, "agent");
            xb_add(&bar[XB_XGEN(b.x)], 1u);
            asm volatile("s_waitcnt vmcnt(0)" ::: "memory");
        } else {
            XB_SPIN(xb_ld(&bar[XB_XGEN(b.x)]) == gen, bar);
            __builtin_amdgcn_fence(__ATOMIC_ACQUIRE, "agent");
            asm volatile("s_waitcnt vmcnt(0)" ::: "memory");
        }
    }
    __syncthreads();
}

DI int crow(int r, int h) { return (r & 3) + 8 * (r >> 2) + 4 * h; }
DI unsigned pk2(float lo, float hi) { f32x2 v = {lo, hi}; bf16x2_t b = __builtin_convertvector(v, bf16x2_t); return __builtin_bit_cast(unsigned, b); }
DI float bf2f(bf16 v) { return __builtin_bit_cast(float, (unsigned)v << 16); }
DI float wave_sum(float v) {
#pragma unroll
    for (int o = 1; o < 64; o <<= 1) v += __shfl_xor(v, o);
    return v;
}
#define MFMA32(a, b, c) __builtin_amdgcn_mfma_f32_32x32x16_bf16((a), (b), (c), 0, 0, 0)
DI s16x4 tr_read(const LAS unsigned char* p) { return __builtin_bit_cast(s16x4, __builtin_amdgcn_ds_read_tr16_b64_v4i16((LAS s16x4*)p)); }

DI void store_tile_bf16(bf16* dst, const f32x16& v, int h) {
    unsigned d[4][2];
#pragma unroll
    for (int g = 0; g < 4; ++g) { d[g][0] = pk2(v[4 * g], v[4 * g + 1]); d[g][1] = pk2(v[4 * g + 2], v[4 * g + 3]); }
#pragma unroll
    for (int pc = 0; pc < 2; ++pc) {
        const auto s0 = __builtin_amdgcn_permlane32_swap(d[2 * pc][0], d[2 * pc + 1][0], false, false);
        const auto s1 = __builtin_amdgcn_permlane32_swap(d[2 * pc][1], d[2 * pc + 1][1], false, false);
        u32x4 o; o[0] = s0[0]; o[1] = s1[0]; o[2] = s0[1]; o[3] = s1[1];
        *(u32x4*)(dst + 16 * pc + 8 * h) = o;
    }
}

template <int I> DI const float* in_ptr() {
    const float* p; const void* ka = (const void*)__builtin_amdgcn_kernarg_segment_ptr();
    asm volatile("s_load_dwordx2 %0, %1, %2\n\ts_waitcnt lgkmcnt(0)" : "=s"(p) : "s"(ka), "i"(I * 8) : "memory");
    return p;
}
enum { IN_X = 0, IN_W_IN, IN_G_Q, IN_W_UQ, IN_G_KV, IN_W_UKV, IN_G_OD, IN_G_OM, IN_W_O, IN_LN1G, IN_LN1B, IN_ROUTER_W, IN_ROUTER_B, IN_W1, IN_W3, IN_W2, IN_WS1, IN_WS3, IN_WS2, IN_LN2G, IN_LN2B };

struct Frame {
    float* out; unsigned char* ws;
    int wave, gw, ngw;
    LAS unsigned char* lds;
};

DI void transpose_item(const float* W, int ldn, int k0, int n0, bf16* dst, int Kd, const float* g, LAS float* scr, int lane) {
#pragma unroll 8
    for (int i = 0; i < 32; ++i) { const int kk = 2 * i + (lane >> 5); float v = W[(size_t)(k0 + kk) * ldn + n0 + (lane & 31)]; if (g) v *= g[k0 + kk]; scr[kk * 33 + (lane & 31)] = v; }
    asm volatile("s_waitcnt lgkmcnt(0)" ::: "memory");
    const int c = lane & 7;
#pragma unroll
    for (int j = 0; j < 4; ++j) { const int n = (lane >> 3) + 8 * j; const LAS float* s = scr + (8 * c) * 33 + n;
        u32x4 o; o.x = pk2(s[0 * 33], s[1 * 33]); o.y = pk2(s[2 * 33], s[3 * 33]); o.z = pk2(s[4 * 33], s[5 * 33]); o.w = pk2(s[6 * 33], s[7 * 33]);
        *(u32x4*)(dst + (size_t)n * Kd + k0 + 8 * c) = o; }
    asm volatile("s_waitcnt lgkmcnt(0)" ::: "memory");
}
DI void transpose_plain(const float* W, int K, int N, bf16* WT, const float* g, int item, LAS float* scr, int lane) {
    const int nblk = N / 32, kb = item / nblk, nb = item % nblk;
    transpose_item(W, N, 64 * kb, 32 * nb, WT + (size_t)(32 * nb) * K, K, g, scr, lane);
}
DI void transpose_gate(const float* W, int s, bf16* WT13, int item, LAS float* scr, int lane) {
    const int kb = item / 8, nb = item % 8, n0 = 32 * nb;
    const int drow = 256 * (n0 >> 7) + 128 * s + (n0 & 127);
    transpose_item(W, 256, 64 * kb, n0, WT13 + (size_t)drow * 1024, 1024, nullptr, scr, lane);
}

DI void transpose_tile64(const float* W, int ldn, int k0, int n0, bf16* dst, int Kd, LAS float* scr, int lane) {
    f32x4 v[16];
    const float* src = W + (size_t)(k0 + (lane >> 4)) * ldn + n0 + 4 * (lane & 15);
#pragma unroll
    for (int i = 0; i < 16; ++i) v[i] = *(const f32x4*)(src + (size_t)(4 * i) * ldn);
#pragma unroll
    for (int i = 0; i < 16; ++i) *(LAS f32x4*)(scr + (4 * i + (lane >> 4)) * 68 + 4 * (lane & 15)) = v[i];
    asm volatile("s_waitcnt lgkmcnt(0)" ::: "memory");
#pragma unroll
    for (int kc = 0; kc < 8; ++kc) { const LAS float* p = scr + (8 * kc) * 68 + lane;
        u32x4 o; o.x = pk2(p[0], p[68]); o.y = pk2(p[2 * 68], p[3 * 68]); o.z = pk2(p[4 * 68], p[5 * 68]); o.w = pk2(p[6 * 68], p[7 * 68]);
        *(u32x4*)(dst + (size_t)lane * Kd + k0 + 8 * kc) = o; }
    asm volatile("s_waitcnt lgkmcnt(0)" ::: "memory");
}
DI void transpose_expert_tile(const float* W, int m, bf16* WT13, bf16* WT2, int q, LAS float* scr, int lane) {
    if (m < 2) { const int kb = q >> 2, nb = q & 3, n0 = 64 * nb; const int drow = 256 * (n0 >> 7) + 128 * m + (n0 & 127);
        transpose_tile64(W, 256, 64 * kb, n0, WT13 + (size_t)drow * 1024, 1024, scr, lane); }
    else { const int kb = q >> 4, nb = q & 15; transpose_tile64(W, 1024, 64 * kb, 64 * nb, WT2 + (size_t)(64 * nb) * 256, 256, scr, lane); }
}

DI void p0_prologue(Frame& F) {
    const float *Fx = in_ptr<IN_X>(), *Fw_in = in_ptr<IN_W_IN>(), *Fg_q = in_ptr<IN_G_Q>(), *Fw_uq = in_ptr<IN_W_UQ>(), *Fg_kv = in_ptr<IN_G_KV>(), *Fw_ukv = in_ptr<IN_W_UKV>(), *Fg_od = in_ptr<IN_G_OD>(), *Fg_om = in_ptr<IN_G_OM>(), *Fw_o = in_ptr<IN_W_O>(), *Frouter_w = in_ptr<IN_ROUTER_W>();
    LAS float* scr = (LAS float*)(F.lds + LDS_WSCR + F.wave * 17408);
    unsigned char* ws = F.ws;
    constexpr int I_IN = 16 * 65, I_UQ = 6 * 24, I_UKV = 2 * 32, I_O = 16 * 32;
    constexpr int I_SMALL = I_IN + I_UQ + I_UKV + I_O;
    for (int it = F.gw; it < I_SMALL; it += F.ngw) {
        int r = it;
        if (r < I_IN) { transpose_plain(Fw_in, 1024, INW, (bf16*)(ws + WS_W_IN_T), nullptr, r, scr, ((int)threadIdx.x & 63)); continue; } r -= I_IN;
        if (r < I_UQ) { transpose_plain(Fw_uq, 384, 768, (bf16*)(ws + WS_W_UQ_T), Fg_q, r, scr, ((int)threadIdx.x & 63)); continue; } r -= I_UQ;
        if (r < I_UKV) { const int kb = r / 32, nb = r % 32;
            transpose_item(Fw_ukv, 1024, 64 * kb, 32 * nb, (bf16*)(ws + WS_W_UKV_T) + (size_t)(32 * nb) * 256 + 128, 256, Fg_kv, scr, ((int)threadIdx.x & 63)); continue; } r -= I_UKV;
        {
            const int kb = r / 32, nb = r % 32; const float* g = (kb < 8) ? Fg_od : (Fg_om - 512);
            transpose_item(Fw_o, 1024, 64 * kb, 32 * nb, (bf16*)(ws + WS_W_O_T) + (size_t)(32 * nb) * 1024, 1024, g, scr, ((int)threadIdx.x & 63)); }
    }
    const int gt = blockIdx.x * 512 + ((int)threadIdx.x), ngt = gridDim.x * 512;
    for (int i = gt; i < (2304 - INW) * 1024 / 8; i += ngt) *(u32x4*)((bf16*)(ws + WS_W_IN_T) + (size_t)INW * 1024 + (size_t)i * 8) = (u32x4){0u, 0u, 0u, 0u};
    for (int i = gt; i < 1024 * 128 / 8; i += ngt) { const int n = i >> 4, c8 = i & 15; *(u32x4*)((bf16*)(ws + WS_W_UKV_T) + (size_t)n * 256 + c8 * 8) = (u32x4){0u, 0u, 0u, 0u}; }
    for (int i = gt; i < NE * 1024 / 8; i += ngt) { const f32x4 a = *(const f32x4*)(Frouter_w + (size_t)i * 8), b = *(const f32x4*)(Frouter_w + (size_t)i * 8 + 4);
        u32x4 o; o.x = pk2(a.x, a.y); o.y = pk2(a.z, a.w); o.z = pk2(b.x, b.y); o.w = pk2(b.z, b.w); *(u32x4*)((bf16*)(ws + WS_W_R) + (size_t)i * 8) = o; }
#pragma unroll 4
    for (int i = gt; i < T * 1024 / 8; i += ngt) { const f32x4 a = *(const f32x4*)(Fx + (size_t)i * 8), b = *(const f32x4*)(Fx + (size_t)i * 8 + 4);
        u32x4 o; o.x = pk2(a.x, a.y); o.y = pk2(a.z, a.w); o.z = pk2(b.x, b.y); o.w = pk2(b.z, b.w); *(u32x4*)((bf16*)(ws + WS_XB) + (size_t)i * 8) = o; }
    for (int i = gt; i < SEQ * 24; i += ngt) {
        const int pos = i / 24, j = i % 24;
        float inv; float* dst;
        if (j < 8) { inv = powf(500000.0f, -(float)(2 * j) / 16.0f); dst = (float*)(ws + WS_ROPE_D) + (size_t)(pos * 8 + j) * 2; }
        else { const int jj = j - 8; inv = powf(500000.0f, -(float)(2 * jj) / 32.0f); dst = (float*)(ws + WS_ROPE_M) + (size_t)(pos * 16 + jj) * 2; }
        const float ang = (float)pos * inv; float sn, cs; sincosf(ang, &sn, &cs);
        dst[0] = cs; dst[1] = sn;
    }
}

namespace pg {
typedef float f32x4 __attribute__((ext_vector_type(4)));
constexpr int BM = 256, BK = 64, HALF = 128, HTB = HALF * BK * 2, STAGE_BYTES = 8 * HTB, NXCD = 8, WGM = 8;
__host__ __device__ __forceinline__ int lds_byte(int r, int c) { const int st = (r >> 4) * 2 + (c >> 5), rr = r & 15, cc = c & 31, ob = rr * 64 + cc * 2; return st * 1024 + (ob ^ (((ob >> 9) & 1) << 5)); }
__host__ __device__ __forceinline__ void stage_rc(int b, int& R, int& C) { const int st = b / 1024, sb = b % 1024, swz = sb ^ (((sb >> 9) & 1) << 5); R = (st >> 1) * 16 + swz / 64; C = (st & 1) * 32 + (swz % 64) / 2; }
__host__ __device__ __forceinline__ int perm32(int rho) { const int n = rho >> 4, i = rho & 15; return 8 * (i >> 2) + 4 * n + (i & 3); }

struct Unit { int pm, pn; const char* B; int kind, rb; };

DI int xcd_deal(int i, int G, int c, int nwg) {
    const long L = (long)i * G + c; if (L >= nwg) return -1;
    int wgid = (int)L; const int q = nwg / NXCD, r = nwg % NXCD, xcd = wgid % NXCD, off = wgid / NXCD;
    return (xcd < r ? xcd * (q + 1) : r * (q + 1) + (xcd - r) * q) + off;
}

template <class Epi, class Sched>
DI void gemm_phase(LAS unsigned char* lds, const char* Abase, int lda, int K, const Sched& S, const Epi& E) {
    int tid = threadIdx.x; asm volatile("" : "+v"(tid));
    const int wid = __builtin_amdgcn_readfirstlane(tid >> 6), lane = tid & 63, wr = wid >> 2, wc = wid & 3, fr = lane & 15, fq = lane >> 4;
    asm volatile("" : "+s"(K), "+s"(lda));
    const int nt = K / BK;
    unsigned voffA[2], voffB[2];
#pragma unroll
    for (int i = 0; i < 2; ++i) { int R, C; stage_rc(tid * 16 + i * 8192, R, C); const int Rb = Epi::PERM ? ((R & ~31) + perm32(R & 31)) : R; voffA[i] = (unsigned)(R * lda + C) * 2u; voffB[i] = (unsigned)(Rb * K + C) * 2u; }
    const size_t hstepA = (size_t)HALF * lda * 2;
    const size_t kstep = (size_t)(BK * 2);
    const size_t hstepB = (size_t)HALF * K * 2;
    const unsigned ldsw = (unsigned)wid * 1024u;
    const int aoff = lds_byte(wr * 64 + fr, fq * 8), boff = lds_byte(wc * 32 + fr, fq * 8);
#define PG_SA(b, h) (((b) * 2 + (h)) * HTB)
#define PG_SB(b, h) ((4 + (b) * 2 + (h)) * HTB)
#define PG_STAGE_A(bufoff, half, kb, nx) do { \
        if constexpr (Sched::GATHER) { const unsigned _o0 = (nx) ? ((half) ? na1[0] : na0[0]) : ((half) ? ca1[0] : ca0[0]), _o1 = (nx) ? ((half) ? na1[1] : na0[1]) : ((half) ? ca1[1] : ca0[1]); \
            __builtin_amdgcn_global_load_lds((const unsigned*)(Abase + (kb) + _o0), (LAS unsigned*)(lds + (bufoff) + ldsw), 16, 0, 0); \
            __builtin_amdgcn_global_load_lds((const unsigned*)(Abase + (kb) + _o1), (LAS unsigned*)(lds + (bufoff) + ldsw + 8192), 16, 0, 0); } \
        else { const char* _b = ((nx) ? nA : cA) + (kb) + ((half) ? hstepA : (size_t)0); _Pragma("unroll") for (int _i = 0; _i < 2; ++_i) \
            __builtin_amdgcn_global_load_lds((const unsigned*)(_b + voffA[_i]), (LAS unsigned*)(lds + (bufoff) + ldsw + _i * 8192), 16, 0, 0); } } while (0)
#define PG_STAGE_B(bufoff, gbase) do { _Pragma("unroll") for (int _i = 0; _i < 2; ++_i) \
        __builtin_amdgcn_global_load_lds((const unsigned*)((const char*)(gbase) + voffB[_i]), (LAS unsigned*)(lds + (bufoff) + ldsw + _i * 8192), 16, 0, 0); } while (0)
#define PG_LDA(dst, b, h) do { _Pragma("unroll") for (int m = 0; m < 4; ++m) _Pragma("unroll") for (int k = 0; k < 2; ++k) dst[m][k] = *(const LAS bf16x8*)(lds + PG_SA(b, h) + aoff + m * 2048 + k * 1024); } while (0)
#define PG_LDB(dst, b, h) do { _Pragma("unroll") for (int n = 0; n < 2; ++n) _Pragma("unroll") for (int k = 0; k < 2; ++k) dst[n][k] = *(const LAS bf16x8*)(lds + PG_SB(b, h) + boff + n * 2048 + k * 1024); } while (0)
#define PG_MMA(ai, bj, At, Bt) do { __builtin_amdgcn_s_setprio(1); _Pragma("unroll") for (int m = 0; m < 4; ++m) _Pragma("unroll") for (int n = 0; n < 2; ++n) _Pragma("unroll") for (int k = 0; k < 2; ++k) \
        acc[ai][bj][m][n] = __builtin_amdgcn_mfma_f32_16x16x32_bf16(Bt[n][k], At[m][k], acc[ai][bj][m][n], 0, 0, 0); __builtin_amdgcn_s_setprio(0); } while (0)
#define PG_WAIT_V(n) asm volatile("s_waitcnt vmcnt(" #n ")" ::: "memory")
#define PG_WAIT_L(n) asm volatile("s_waitcnt lgkmcnt(" #n ")" ::: "memory")
#define PG_BAR __builtin_amdgcn_s_barrier()
#define PG_SCHED __builtin_amdgcn_sched_barrier(0)
    Unit cur, nxt; int ui = 0;
    if (!S.next(0, cur)) return;
    f32x4 acc[2][2][4][2];
#pragma unroll
    for (int a = 0; a < 2; ++a)
#pragma unroll
        for (int b = 0; b < 2; ++b)
#pragma unroll
            for (int m = 0; m < 4; ++m)
#pragma unroll
                for (int n = 0; n < 2; ++n) acc[a][b][m][n] = (f32x4){0.f, 0.f, 0.f, 0.f};
    bf16x8 At[4][2], B0[2][2], B1[2][2];
    unsigned ca0[2] = {0u, 0u}, ca1[2] = {0u, 0u}, na0[2] = {0u, 0u}, na1[2] = {0u, 0u};
    const char* cA = Abase; const char* nA = Abase;
    if constexpr (Sched::GATHER) {
#pragma unroll
        for (int i = 0; i < 2; ++i) { int R, C; stage_rc(tid * 16 + i * 8192, R, C); ca0[i] = (unsigned)(S.arow(cur, R) * lda + C) * 2u; ca1[i] = (unsigned)(S.arow(cur, HALF + R) * lda + C) * 2u; na0[i] = ca0[i]; na1[i] = ca1[i]; }
    } else { cA = Abase + (size_t)S.arow(cur, 0) * lda * 2; nA = cA; }
    const char* cB = cur.B;
    PG_STAGE_B(PG_SB(0, 0), cB); PG_STAGE_B(PG_SB(0, 1), cB + hstepB); PG_STAGE_A(PG_SA(0, 0), 0, (size_t)0, false); PG_STAGE_A(PG_SA(0, 1), 1, (size_t)0, false);
    if (wr == 1) PG_BAR;
    PG_WAIT_V(2); PG_BAR;
    PG_STAGE_B(PG_SB(1, 0), cB + kstep); PG_STAGE_A(PG_SA(1, 0), 0, kstep, false); PG_STAGE_B(PG_SB(1, 1), cB + hstepB + kstep);
    PG_WAIT_V(6); PG_BAR;
    for (;;) {
        const bool has_next = S.next(ui + 1, nxt);
        if (has_next) {
            if constexpr (Sched::GATHER) {
#pragma unroll
                for (int i = 0; i < 2; ++i) { int R, C; stage_rc(tid * 16 + i * 8192, R, C); na0[i] = (unsigned)(S.arow(nxt, R) * lda + C) * 2u; na1[i] = (unsigned)(S.arow(nxt, HALF + R) * lda + C) * 2u; }
            } else nA = Abase + (size_t)S.arow(nxt, 0) * lda * 2;
        }
        const char* nB = has_next ? nxt.B : cB;
        for (int t = 0; t < nt; t += 2) {
            const bool last = (t == nt - 2);
            const size_t kb1 = (size_t)(t + 1) * kstep;
            const size_t kb2 = last ? 0 : (size_t)(t + 2) * kstep, kb3 = kb2 + kstep;
            const char* b2 = last ? nB : cB + (size_t)(t + 2) * kstep; const char* b3 = b2 + kstep;
            if constexpr (Epi::MIDK >= 0) { if (t == Epi::MIDK) E.midk(acc, cur, wr, wc, fr, fq); }
            PG_LDB(B0, 0, 0); PG_LDB(B1, 0, 1); PG_SCHED; PG_LDA(At, 0, 0); PG_STAGE_A(PG_SA(1, 1), 1, kb1, false);
            PG_WAIT_V(8); PG_WAIT_L(0); PG_BAR; PG_MMA(0, 0, At, B0); PG_MMA(0, 1, At, B1); PG_BAR; PG_SCHED;
            PG_LDA(At, 0, 1); PG_STAGE_B(PG_SB(0, 0), b2); PG_STAGE_B(PG_SB(0, 1), b2 + hstepB); PG_STAGE_A(PG_SA(0, 0), 0, kb2, last);
            PG_WAIT_V(8); PG_WAIT_L(0); PG_BAR; PG_MMA(1, 0, At, B0); PG_MMA(1, 1, At, B1); PG_BAR; PG_SCHED;
            PG_LDB(B0, 1, 0); PG_LDB(B1, 1, 1); PG_SCHED; PG_LDA(At, 1, 0); PG_STAGE_A(PG_SA(0, 1), 1, kb2, last);
            PG_WAIT_V(8); PG_WAIT_L(0); PG_BAR; PG_MMA(0, 0, At, B0); PG_MMA(0, 1, At, B1); PG_BAR; PG_SCHED;
            PG_LDA(At, 1, 1); PG_STAGE_B(PG_SB(1, 0), b3); PG_STAGE_B(PG_SB(1, 1), b3 + hstepB); PG_STAGE_A(PG_SA(1, 0), 0, kb3, last);
            PG_WAIT_V(8); PG_WAIT_L(0); PG_BAR; PG_MMA(1, 0, At, B0); PG_MMA(1, 1, At, B1); PG_BAR; PG_SCHED;
        }
        if (wr == 0) PG_BAR;
        E(acc, cur, wr, wc, fr, fq);
        if (!has_next) break;
#pragma unroll
        for (int a = 0; a < 2; ++a)
#pragma unroll
            for (int b = 0; b < 2; ++b)
#pragma unroll
                for (int m = 0; m < 4; ++m)
#pragma unroll
                    for (int n = 0; n < 2; ++n) acc[a][b][m][n] = (f32x4){0.f, 0.f, 0.f, 0.f};
        cur = nxt; cB = nB; cA = nA; ++ui;
        if constexpr (Sched::GATHER) {
#pragma unroll
            for (int i = 0; i < 2; ++i) { ca0[i] = na0[i]; ca1[i] = na1[i]; }
        }
        if (wr == 1) PG_BAR;
    }
    PG_WAIT_V(0);
    PG_BAR;
#undef PG_SA
#undef PG_SB
#undef PG_STAGE_A
#undef PG_STAGE_B
#undef PG_LDA
#undef PG_LDB
#undef PG_MMA
#undef PG_WAIT_V
#undef PG_WAIT_L
#undef PG_BAR
#undef PG_SCHED
}
}

DI float sigmoidf_(float x) { return 1.0f / (1.0f + __expf(-x)); }
#define TOP8_INSERT(cv_, ce_) do { float cv = (cv_); int ce = (ce_); _Pragma("unroll") for (int k_ = 0; k_ < 8; ++k_) { const bool sw = cv > tv[k_] || (cv == tv[k_] && ce < ti[k_]); \
        const float t1 = sw ? tv[k_] : cv; const int i1 = sw ? ti[k_] : ce; tv[k_] = sw ? cv : tv[k_]; ti[k_] = sw ? ce : ti[k_]; cv = t1; ce = i1; } } while (0)
DI void p5c_route(Frame& F, const int tb0 = -1, const int tend_ = 0, const int tstep_ = 0) {
    unsigned char* ws = F.ws;
    const float* LG = (const float*)(ws + WS_LOGITS); const float* rbias = in_ptr<IN_ROUTER_B>();
    int* EIDX = (int*)(ws + WS_EIDX); float* GWT = (float*)(ws + WS_GWT); int* RANK = (int*)(ws + WS_RANK);
    unsigned* total = (unsigned*)(ws + WS_CTL) + CW_TOTAL;
    LAS float* CH = (LAS float*)(F.lds);
    LAS float* GS = (LAS float*)(F.lds + 128 * 257 * 4);
    const int tid = (int)threadIdx.x;
    const int tbA = tb0 < 0 ? (int)blockIdx.x * 128 : tb0, tbE = tb0 < 0 ? T : tend_, tbS = tb0 < 0 ? (int)gridDim.x * 128 : tstep_;
    for (int tb = tbA; tb < tbE; tb += tbS) {
        __syncthreads();
#pragma unroll 4
        for (int i = 0; i < 16; ++i) { const int c4 = tid + 512 * i, tok = c4 >> 6, e0 = (c4 & 63) * 4;
            const f32x4 x = *(const f32x4*)(LG + (size_t)(tb + tok) * 256 + e0), bb = *(const f32x4*)(rbias + e0);
            LAS float* d = CH + tok * 257 + e0;
            d[0] = sigmoidf_(x.x) + bb.x; d[1] = sigmoidf_(x.y) + bb.y; d[2] = sigmoidf_(x.z) + bb.z; d[3] = sigmoidf_(x.w) + bb.w; }
        __syncthreads();
        const int tok = tid >> 2, j = tid & 3;
        const LAS float* row = CH + tok * 257;
        {
#pragma unroll
            for (int gg = 0; gg < 2; ++gg) { float a = -INFINITY, b = -INFINITY; const LAS float* p = row + 64 * j + 32 * gg;
                for (int i = 0; i < 32; ++i) { const float c = p[i]; if (c > a) { b = a; a = c; } else if (c > b) b = c; }
                GS[tok * 8 + 2 * j + gg] = a + b; }
        }
        __syncthreads();
        float gs[8];
#pragma unroll
        for (int g = 0; g < 8; ++g) gs[g] = GS[tok * 8 + g];
        int mygrp = 0, nsel = 0;
#pragma unroll
        for (int g = 0; g < 8; ++g) { int cnt = 0;
#pragma unroll
            for (int g2 = 0; g2 < 8; ++g2) cnt += (gs[g2] > gs[g] || (gs[g2] == gs[g] && g2 < g)) ? 1 : 0;
            if (cnt < 4) { if (nsel == j) mygrp = g; ++nsel; } }
        float tv[8]; int ti[8];
#pragma unroll
        for (int k = 0; k < 8; ++k) { tv[k] = -INFINITY; ti[k] = 0x7fffffff; }
        { const LAS float* p = row + 32 * mygrp; for (int i = 0; i < 32; ++i) TOP8_INSERT(p[i], 32 * mygrp + i); }
        float ov[3][8]; int oi[3][8];
#pragma unroll
        for (int q = 0; q < 3; ++q)
#pragma unroll
            for (int k = 0; k < 8; ++k) { ov[q][k] = __shfl_xor(tv[k], q + 1); oi[q][k] = __shfl_xor(ti[k], q + 1); }
#pragma unroll
        for (int q = 0; q < 3; ++q)
#pragma unroll
            for (int k = 0; k < 8; ++k) TOP8_INSERT(ov[q][k], oi[q][k]);
        if (j == 0) {
            float sc[8], ssum = 0.f;
#pragma unroll
            for (int k = 0; k < 8; ++k) { sc[k] = tv[k] - rbias[ti[k]]; ssum += sc[k]; }
            const float sinv = 2.5f / ssum;
            unsigned rk[8];
#pragma unroll
            for (int k = 0; k < 8; ++k) rk[k] = __hip_atomic_fetch_add(total + ti[k] * 64, 1u, __ATOMIC_RELAXED, __HIP_MEMORY_SCOPE_AGENT);
            const size_t t = (size_t)(tb + tok);
#pragma unroll
            for (int k = 0; k < 8; ++k) { EIDX[t * 8 + k] = ti[k]; RANK[t * 8 + k] = (int)rk[k]; GWT[t * 8 + k] = sc[k] * sinv; }
        }
    }
}
#undef TOP8_INSERT
DI void build_tab(Frame& F) {
    LAS int* tab = (LAS int*)(F.lds + LDS_TAB); LAS int* ctab = (LAS int*)(F.lds + LDS_TAB + 1040);
    const unsigned* total = (const unsigned*)(F.ws + WS_CTL) + CW_TOTAL;
    const int e = (int)threadIdx.x;
    int tot = 0;
    if (e < NE) tot = (int)total[e * 64];
    __syncthreads();
    if (e < NE) { tab[e] = (tot + 255) >> 8; ctab[e] = tot; }
    __syncthreads();
    int acc = 0, cacc = 0;
    if (e < NE) {
        for (int i = 0; i < NE; i += 4) { const i32x4 a = *(const LAS i32x4*)(tab + i), c = *(const LAS i32x4*)(ctab + i);
#pragma unroll
            for (int j = 0; j < 4; ++j) if (i + j < e) { acc += a[j]; cacc += c[j]; } }
    }
    __syncthreads();
    if (e < NE) { tab[e] = acc; ctab[e] = cacc; if (e == NE - 1) { tab[NE] = acc + ((tot + 255) >> 8); ctab[NE] = cacc + tot; } }
    __syncthreads();
}
DI int find_expert(const LAS int* tab, int blk) {
    int lo = 0, hi = NE - 1;
    while (lo < hi) { const int mid = (lo + hi + 1) >> 1; if (tab[mid] <= blk) lo = mid; else hi = mid - 1; }
    return lo;
}
DI void p6_scatter(Frame& F) {
    unsigned char* ws = F.ws;
    build_tab(F);
    const LAS int* tab = (const LAS int*)(F.lds + LDS_TAB);
    const unsigned* total = (const unsigned*)(ws + WS_CTL) + CW_TOTAL;
    const int* EIDX = (const int*)(ws + WS_EIDX); const int* RANK = (const int*)(ws + WS_RANK); const unsigned* GWTB = (const unsigned*)(ws + WS_GWT); u32x2* RI = (u32x2*)(ws + WS_ROWINFO);
    const int gt = blockIdx.x * 512 + ((int)threadIdx.x), ngt = gridDim.x * 512;
    const LAS int* ctab = (const LAS int*)(F.lds + LDS_TAB + 1040); int* POSC = (int*)(ws + WS_RANK);
    for (int idx = gt; idx < T * 8; idx += ngt) { const int e = EIDX[idx]; const int rk = RANK[idx]; u32x2 v; v.x = (unsigned)idx; v.y = GWTB[idx]; RI[(size_t)tab[e] * 256 + rk] = v;
        POSC[idx] = ctab[e] + rk; }
    { const size_t sbase = (size_t)tab[NE] * 256; for (int t = gt; t < T; t += ngt) { u32x2 v; v.x = (unsigned)t * 8u; v.y = 0u; RI[sbase + t] = v; } }
    for (int idx = gt; idx < NE * 256; idx += ngt) { const int e = idx >> 8, i = idx & 255; const int tot = (int)total[e * 64]; const int padded = ((tot + 255) >> 8) << 8;
        if (tot + i < padded) { u32x2 v; v.x = 0xffffffffu; v.y = 0u; RI[(size_t)tab[e] * 256 + tot + i] = v; } }
}
typedef pg::f32x4 accv;
struct DenseSched {
    static constexpr bool GATHER = false;
    int nM, nN, nwg, G, c; const char* Bt; size_t tstepB;
    DI void init(int M, int N, int K, const bf16* Bt_, int G_, int c_) { nM = M / 256; nN = N / 256; nwg = nM * nN; G = G_; c = c_; Bt = (const char*)Bt_; tstepB = (size_t)256 * K * 2; }
    DI bool next(int i, pg::Unit& u) const {
        const int wgid = pg::xcd_deal(i, G, c, nwg); if (wgid < 0) return false;
        const int nig = pg::WGM * nN, gid = wgid / nig, fm = gid * pg::WGM, gsz = (nM - fm) < pg::WGM ? (nM - fm) : pg::WGM;
        u.pm = fm + ((wgid % nig) % gsz); u.pn = (wgid % nig) / gsz; u.B = Bt + (size_t)u.pn * tstepB; u.kind = 0; u.rb = u.pm; return true;
    }
    DI int arow(const pg::Unit& u, int r) const { return u.pm * 256 + r; }
};
struct Moe1Sched {
    static constexpr bool GATHER = true;
    const LAS int* tab; const u32x2* rowinfo; const char* W13; const char* WS13; int nR, nblk, nwg, G, c;
    DI bool next(int i, pg::Unit& u) const {
        const int L = pg::xcd_deal(i, G, c, nwg); if (L < 0) return false;
        if (L < nR) { const int blk = L >> 1; u.pn = L & 1; u.pm = blk; u.rb = blk; u.kind = 0; const int e = find_expert(tab, blk); u.B = W13 + ((size_t)e * 512 + (size_t)u.pn * 256) * 1024 * 2; }
        else { const int Ls = L - nR; u.pn = Ls & 1; u.rb = Ls >> 1; u.pm = nblk + u.rb; u.kind = 1; u.B = WS13 + (size_t)u.pn * 256 * 1024 * 2; }
        return true;
    }
    DI int arow(const pg::Unit& u, int r) const { const int info = (int)rowinfo[(unsigned)(u.pm * 256 + r)].x; return info < 0 ? 0 : (info >> 3); }
};
struct Moe2Sched {
    static constexpr bool GATHER = false;
    const LAS int* tab; const char* W2; int nblk, G, c;
    DI bool next(int i, pg::Unit& u) const {
        const int blk = pg::xcd_deal(i >> 2, G, c, nblk); if (blk < 0) return false;
        u.pm = blk; u.pn = i & 3; u.rb = blk; u.kind = 0; const int e = find_expert(tab, blk); u.B = W2 + ((size_t)e * 1024 + (size_t)u.pn * 256) * 256 * 2; return true;
    }
    DI int arow(const pg::Unit& u, int r) const { return u.pm * 256 + r; }
};

DI u32x4 pack8(const accv& a, const accv& b) { u32x4 w; w.x = pk2(a[0], a[1]); w.y = pk2(a[2], a[3]); w.z = pk2(b[0], b[1]); w.w = pk2(b[2], b[3]); return w; }
DI accv shfl4(const accv& v, int mask) {
    const int lane = (int)threadIdx.x & 63; accv r;
#pragma unroll
    for (int i = 0; i < 4; ++i) { const unsigned x = __float_as_uint(v[i]);
        if (mask == 32) { const auto rr = __builtin_amdgcn_permlane32_swap(x, x, false, false); r[i] = __uint_as_float((lane & 32) ? rr[0] : rr[1]); }
        else            { const auto rr = __builtin_amdgcn_permlane16_swap(x, x, false, false); r[i] = __uint_as_float((lane & 16) ? rr[0] : rr[1]); } }
    return r;
}

struct EpiProj {
    static constexpr bool PERM = true; static constexpr int MIDK = -1;
    unsigned char* ws;
    DI void midk(accv (&)[2][2][4][2], const pg::Unit&, int, int, int, int) const {}
    DI void operator()(const accv (&acc)[2][2][4][2], const pg::Unit& u, int wr, int wc, int fr, int fq) const {
        const int pn = u.pn;
        if (pn == 8 && wc != 0) return;
#pragma unroll
        for (int ai = 0; ai < 2; ++ai)
#pragma unroll
            for (int m = 0; m < 4; ++m) {
                const int row = u.pm * 256 + ai * 128 + wr * 64 + m * 16 + fr; const int pos = row & (SEQ - 1);
                if (pn < 4) {
                    bf16* dst = (bf16*)(ws + (pn < 2 ? WS_QD : WS_KD)) + (size_t)row * 512 + (pn & 1) * 256 + wc * 32 + 8 * fq;
                    const float sc = pn < 2 ? CD2 : 1.0f;
                    accv c0, c1, s0, s1;
                    if ((wc & 1) == 0) { const float* tab = (const float*)(ws + WS_ROPE_D) + (size_t)pos * 16;
                        const accv t0 = *(const accv*)(tab), t1 = *(const accv*)(tab + 4), t2 = *(const accv*)(tab + 8), t3 = *(const accv*)(tab + 12);
                        c0 = (accv){t0[0], t0[2], t1[0], t1[2]}; s0 = (accv){t0[1], t0[3], t1[1], t1[3]}; c1 = (accv){t2[0], t2[2], t3[0], t3[2]}; s1 = (accv){t2[1], t2[3], t3[1], t3[3]}; }
#pragma unroll
                    for (int bj = 0; bj < 2; ++bj) {
                        accv v0 = acc[ai][bj][m][0], v1 = acc[ai][bj][m][1];
                        if ((wc & 1) == 0) {
                            const accv p0 = shfl4(v0, 16), p1 = shfl4(v1, 16);
                            if (fq == 0) { v0 = v0 * c0 - p0 * s0; v1 = v1 * c1 - p1 * s1; }
                            else if (fq == 1) { v0 = v0 * c0 + p0 * s0; v1 = v1 * c1 + p1 * s1; }
                        }
                        v0 = v0 * sc; v1 = v1 * sc;
                        *(u32x4*)(dst + bj * 128) = pack8(v0, v1);
                    }
                } else if (pn < 6) {
                    bf16* dst = (bf16*)(ws + WS_VD) + (size_t)row * 512 + (pn - 4) * 256 + wc * 32 + 8 * fq;
#pragma unroll
                    for (int bj = 0; bj < 2; ++bj) *(u32x4*)(dst + bj * 128) = pack8(acc[ai][bj][m][0], acc[ai][bj][m][1]);
                } else if (pn < 8) {
                    bf16* dst = (bf16*)(ws + WS_CQKV) + (size_t)row * 512 + (pn - 6) * 256 + wc * 32 + 8 * fq;
                    float* sq = (float*)(ws + WS_SSQC) + (size_t)row * 16 + (pn - 6) * 8 + wc;
#pragma unroll
                    for (int bj = 0; bj < 2; ++bj) { const accv v0 = acc[ai][bj][m][0], v1 = acc[ai][bj][m][1];
                        float s = (v0[0] * v0[0] + v0[1] * v0[1]) + (v0[2] * v0[2] + v0[3] * v0[3]) + (v1[0] * v1[0] + v1[1] * v1[1]) + (v1[2] * v1[2] + v1[3] * v1[3]);
                        s += __shfl_xor(s, 16); s += __shfl_xor(s, 32);
                        if (fq == 0) sq[bj * 4] = s;
                        *(u32x4*)(dst + bj * 128) = pack8(v0, v1); }
                } else {
                    const float* tab = (const float*)(ws + WS_ROPE_M) + (size_t)pos * 32 + 16 * (fq & 1);
                    const accv t0 = *(const accv*)(tab), t1 = *(const accv*)(tab + 4), t2 = *(const accv*)(tab + 8), t3 = *(const accv*)(tab + 12);
                    const accv c0 = {t0[0], t0[2], t1[0], t1[2]}, s0 = {t0[1], t0[3], t1[1], t1[3]}, c1 = {t2[0], t2[2], t3[0], t3[2]}, s1 = {t2[1], t2[3], t3[1], t3[3]};
                    accv v0 = acc[ai][0][m][0], v1 = acc[ai][0][m][1];
                    const accv p0 = shfl4(v0, 32), p1 = shfl4(v1, 32);
                    if (fq < 2) { v0 = v0 * c0 - p0 * s0; v1 = v1 * c1 - p1 * s1; } else { v0 = v0 * c0 + p0 * s0; v1 = v1 * c1 + p1 * s1; }
                    *(u32x4*)((bf16*)(ws + WS_KPE) + (size_t)row * 32 + 8 * fq) = pack8(v0, v1);
                }
            }
    }
};
struct EpiQ {
    static constexpr bool PERM = true; static constexpr int MIDK = -1;
    unsigned char* ws;
    DI void midk(accv (&)[2][2][4][2], const pg::Unit&, int, int, int, int) const {}
    DI void operator()(const accv (&acc)[2][2][4][2], const pg::Unit& u, int wr, int wc, int fr, int fq) const {
#pragma unroll
        for (int ai = 0; ai < 2; ++ai)
#pragma unroll
            for (int m = 0; m < 4; ++m) {
                const int row = u.pm * 256 + ai * 128 + wr * 64 + m * 16 + fr; const int pos = row & (SEQ - 1);
                const float rq = ((const float*)(ws + WS_RQRK))[(size_t)row * 2];
                const float* tab = (const float*)(ws + WS_ROPE_M) + (size_t)pos * 32 + 16 * (fq & 1);
                const accv t0 = *(const accv*)(tab), t1 = *(const accv*)(tab + 4), t2 = *(const accv*)(tab + 8), t3 = *(const accv*)(tab + 12);
                const accv c0 = {t0[0], t0[2], t1[0], t1[2]}, s0 = {t0[1], t0[3], t1[1], t1[3]}, c1 = {t2[0], t2[2], t3[0], t3[2]}, s1 = {t2[1], t2[3], t3[1], t3[3]};
#pragma unroll
                for (int bj = 0; bj < 2; ++bj) {
                    const int G = 8 * u.pn + 4 * bj + wc;
                    accv v0 = acc[ai][bj][m][0] * rq, v1 = acc[ai][bj][m][1] * rq;
                    if (G % 3 == 2) {
                        const accv p0 = shfl4(v0, 32), p1 = shfl4(v1, 32);
                        if (fq < 2) { v0 = v0 * c0 - p0 * s0; v1 = v1 * c1 - p1 * s1; } else { v0 = v0 * c0 + p0 * s0; v1 = v1 * c1 + p1 * s1; }
                    }
                    *(u32x4*)((bf16*)(ws + WS_QM) + (size_t)row * 768 + 32 * G + 8 * fq) = pack8(v0, v1);
                }
            }
    }
};
struct EpiKV {
    static constexpr bool PERM = true; static constexpr int MIDK = -1;
    unsigned char* ws;
    DI void midk(accv (&)[2][2][4][2], const pg::Unit&, int, int, int, int) const {}
    DI void operator()(const accv (&acc)[2][2][4][2], const pg::Unit& u, int wr, int wc, int fr, int fq) const {
        float sc[2][4];
#pragma unroll
        for (int ai = 0; ai < 2; ++ai)
#pragma unroll
            for (int m = 0; m < 4; ++m) sc[ai][m] = ((const float*)(ws + WS_RQRK))[(size_t)(u.pm * 256 + ai * 128 + wr * 64 + m * 16 + fr) * 2 + 1];
        asm volatile("" : "+v"(sc[0][0]), "+v"(sc[0][1]), "+v"(sc[0][2]), "+v"(sc[0][3]), "+v"(sc[1][0]), "+v"(sc[1][1]), "+v"(sc[1][2]), "+v"(sc[1][3]));
#pragma unroll
        for (int ai = 0; ai < 2; ++ai)
#pragma unroll
            for (int m = 0; m < 4; ++m) {
                const int row = u.pm * 256 + ai * 128 + wr * 64 + m * 16 + fr;
                const float rk = sc[ai][m];
                bf16* dst = (bf16*)(ws + WS_KVM) + (size_t)row * 1024 + u.pn * 256 + wc * 32 + 8 * fq;
#pragma unroll
                for (int bj = 0; bj < 2; ++bj) *(u32x4*)(dst + bj * 128) = pack8(acc[ai][bj][m][0] * rk, acc[ai][bj][m][1] * rk);
            }
    }
};
struct EpiWo {
    static constexpr bool PERM = true; static constexpr int MIDK = 8;
    unsigned char* ws; bf16* mix;
    DI void scales(int row, float& f, float& rm) const { const f32x2 v = *(const f32x2*)((const float*)(ws + WS_RDRM) + (size_t)row * 2); f = v[0]; rm = v[1]; }
    DI void midk(accv (&acc)[2][2][4][2], const pg::Unit& u, int wr, int wc, int fr, int fq) const {
        float sf[2][4];
#pragma unroll
        for (int ai = 0; ai < 2; ++ai)
#pragma unroll
            for (int m = 0; m < 4; ++m) { float rm_; scales(u.pm * 256 + ai * 128 + wr * 64 + m * 16 + fr, sf[ai][m], rm_); }
        asm volatile("" : "+v"(sf[0][0]), "+v"(sf[0][1]), "+v"(sf[0][2]), "+v"(sf[0][3]), "+v"(sf[1][0]), "+v"(sf[1][1]), "+v"(sf[1][2]), "+v"(sf[1][3]));
#pragma unroll
        for (int ai = 0; ai < 2; ++ai)
#pragma unroll
            for (int m = 0; m < 4; ++m) { const float f = sf[ai][m];
#pragma unroll
                for (int bj = 0; bj < 2; ++bj)
#pragma unroll
                    for (int n = 0; n < 2; ++n) acc[ai][bj][m][n] = acc[ai][bj][m][n] * f; }
    }
    DI void operator()(const accv (&acc)[2][2][4][2], const pg::Unit& u, int wr, int wc, int fr, int fq) const {
        float sr[2][4];
#pragma unroll
        for (int ai = 0; ai < 2; ++ai)
#pragma unroll
            for (int m = 0; m < 4; ++m) { float f_; scales(u.pm * 256 + ai * 128 + wr * 64 + m * 16 + fr, f_, sr[ai][m]); }
        asm volatile("" : "+v"(sr[0][0]), "+v"(sr[0][1]), "+v"(sr[0][2]), "+v"(sr[0][3]), "+v"(sr[1][0]), "+v"(sr[1][1]), "+v"(sr[1][2]), "+v"(sr[1][3]));
#pragma unroll
        for (int ai = 0; ai < 2; ++ai)
#pragma unroll
            for (int m = 0; m < 4; ++m) { const int row = u.pm * 256 + ai * 128 + wr * 64 + m * 16 + fr; const float rm = sr[ai][m];
                bf16* dst = mix + (size_t)row * 1024 + u.pn * 256 + wc * 32 + 8 * fq;
#pragma unroll
                for (int bj = 0; bj < 2; ++bj) *(u32x4*)(dst + bj * 128) = pack8(acc[ai][bj][m][0] * rm, acc[ai][bj][m][1] * rm); }
    }
};
struct EpiRouter {
    static constexpr bool PERM = false; static constexpr int MIDK = -1;
    float* lg;
    DI void midk(accv (&)[2][2][4][2], const pg::Unit&, int, int, int, int) const {}
    DI void operator()(const accv (&acc)[2][2][4][2], const pg::Unit& u, int wr, int wc, int fr, int fq) const {
#pragma unroll
        for (int ai = 0; ai < 2; ++ai)
#pragma unroll
            for (int m = 0; m < 4; ++m) { const int row = u.pm * 256 + ai * 128 + wr * 64 + m * 16 + fr; float* p = lg + (size_t)row * 256 + wc * 32 + 4 * fq;
#pragma unroll
                for (int bj = 0; bj < 2; ++bj)
#pragma unroll
                    for (int n = 0; n < 2; ++n) *(accv*)(p + bj * 128 + n * 16) = acc[ai][bj][m][n]; }
    }
};
DI float silu1(float a) { return a * __builtin_amdgcn_rcpf(1.0f + __builtin_amdgcn_exp2f(a * -LOG2E)); }
DI accv silu4(const accv& a) { accv r; r[0] = silu1(a[0]); r[1] = silu1(a[1]); r[2] = silu1(a[2]); r[3] = silu1(a[3]); return r; }
struct EpiGate {
    static constexpr bool PERM = true; static constexpr int MIDK = -1;
    bf16* hb; bf16* hs;
    DI void midk(accv (&)[2][2][4][2], const pg::Unit&, int, int, int, int) const {}
    DI void operator()(const accv (&acc)[2][2][4][2], const pg::Unit& u, int wr, int wc, int fr, int fq) const {
        bf16* base = (u.kind ? hs : hb) + (size_t)u.rb * 256 * 256 + u.pn * 128 + wc * 32 + 8 * fq;
#pragma unroll
        for (int ai = 0; ai < 2; ++ai)
#pragma unroll
            for (int m = 0; m < 4; ++m) { const int r = ai * 128 + wr * 64 + m * 16 + fr;
                const accv h0 = silu4(acc[ai][0][m][0]) * acc[ai][1][m][0], h1 = silu4(acc[ai][0][m][1]) * acc[ai][1][m][1];
                *(u32x4*)(base + (size_t)r * 256) = pack8(h0, h1); }
    }
};
struct EpiShared2 {
    static constexpr bool PERM = true; static constexpr int MIDK = -1;
    bf16* shb;
    DI void midk(accv (&)[2][2][4][2], const pg::Unit&, int, int, int, int) const {}
    DI void operator()(const accv (&acc)[2][2][4][2], const pg::Unit& u, int wr, int wc, int fr, int fq) const {
#pragma unroll
        for (int ai = 0; ai < 2; ++ai)
#pragma unroll
            for (int m = 0; m < 4; ++m) { const int row = u.pm * 256 + ai * 128 + wr * 64 + m * 16 + fr; bf16* dst = shb + (size_t)row * H1_LD + u.pn * 256 + wc * 32 + 8 * fq;
#pragma unroll
                for (int bj = 0; bj < 2; ++bj) *(u32x4*)(dst + bj * 128) = pack8(acc[ai][bj][m][0], acc[ai][bj][m][1]); }
    }
};
constexpr float Y2_SCALE = 32.0f;
DI u32x2 pack8_fp8(const accv& a, const accv& b) { int w0 = 0, w1 = 0;
    w0 = __builtin_amdgcn_cvt_pk_fp8_f32(a[0], a[1], w0, false); w0 = __builtin_amdgcn_cvt_pk_fp8_f32(a[2], a[3], w0, true);
    w1 = __builtin_amdgcn_cvt_pk_fp8_f32(b[0], b[1], w1, false); w1 = __builtin_amdgcn_cvt_pk_fp8_f32(b[2], b[3], w1, true);
    u32x2 r; r.x = (unsigned)w0; r.y = (unsigned)w1; return r; }
struct EpiY2 {
    static constexpr bool PERM = true; static constexpr int MIDK = -1;
    const u32x2* rowinfo; unsigned char* y2c;
    DI void midk(accv (&)[2][2][4][2], const pg::Unit&, int, int, int, int) const {}
    DI void operator()(const accv (&acc)[2][2][4][2], const pg::Unit& u, int wr, int wc, int fr, int fq) const {
        u32x2 iw[2][4];
#pragma unroll
        for (int ai = 0; ai < 2; ++ai)
#pragma unroll
            for (int m = 0; m < 4; ++m) iw[ai][m] = rowinfo[(unsigned)(u.rb * 256 + ai * 128 + wr * 64 + m * 16 + fr)];
#pragma unroll
        for (int ai = 0; ai < 2; ++ai)
#pragma unroll
            for (int m = 0; m < 4; ++m) { const int info = (int)iw[ai][m][0];
                if (info >= 0) { const float w = __uint_as_float(iw[ai][m][1]) * Y2_SCALE;     unsigned char* dst = y2c + (size_t)info * 1024 + u.pn * 256 + wc * 32 + 8 * fq;
#pragma unroll
                    for (int bj = 0; bj < 2; ++bj) *(u32x2*)(dst + bj * 128) = pack8_fp8(acc[ai][bj][m][0] * w, acc[ai][bj][m][1] * w); } }
    }
};

DI void p1_proj(Frame& F) {
    DenseSched S; S.init(T, 2304, 1024, (const bf16*)(F.ws + WS_W_IN_T), gridDim.x, blockIdx.x);
    EpiProj E{F.ws};
    pg::gemm_phase<EpiProj, DenseSched>(F.lds, (const char*)(F.ws + WS_XB), 1024, 1024, S, E);
}
DI void rqrk_panel(Frame& F, int pm) {
    const int r = ((int)threadIdx.x) & 255, half = ((int)threadIdx.x) >> 8; const size_t row = (size_t)pm * 256 + r;
    const float* sq = (const float*)(F.ws + WS_SSQC) + row * 16; float v;
    if (half == 0) { const f32x4 a = *(const f32x4*)sq, b = *(const f32x4*)(sq + 4), c = *(const f32x4*)(sq + 8);
        v = CM2 / sqrtf((((a.x + a.y) + (a.z + a.w)) + ((b.x + b.y) + (b.z + b.w)) + ((c.x + c.y) + (c.z + c.w))) * (1.0f / 384.0f) + RMS_EPS); }
    else { const f32x4 d = *(const f32x4*)(sq + 12); v = 1.0f / sqrtf(((d.x + d.y) + (d.z + d.w)) * (1.0f / 128.0f) + RMS_EPS); }
    ((float*)(F.ws + WS_RQRK))[row * 2 + half] = v;
}
constexpr int KV2_ROW = 272, KV2_HALF = 512 * KV2_ROW;
DI void p2b_kv_v2(Frame& F) {
    unsigned char* ws = F.ws;
    int tid = threadIdx.x; asm volatile("" : "+v"(tid));
    const int lane = tid & 63, l31 = lane & 31, h = lane >> 5, w = __builtin_amdgcn_readfirstlane(tid >> 6);
    LAS unsigned char* lds = F.lds;
    const char* wbase = (const char*)(ws + WS_W_UKV_T);
    const unsigned boff = (unsigned)(l31 * KV2_ROW + h * 16);
    f32x16 zero;
#pragma unroll
    for (int r = 0; r < 16; ++r) zero[r] = 0.f;
    for (int k = 0;; ++k) {
        const int blk = pg::xcd_deal(k, gridDim.x, blockIdx.x, T / 256); if (blk < 0) break;
        const size_t row = (size_t)blk * 256 + 32 * w + l31;
        bf16x8 af[8]; float rk;
        { const bf16* ap = (const bf16*)(ws + WS_CQKV) + row * 512 + 384 + 8 * h;
#pragma unroll
          for (int s_ = 0; s_ < 8; ++s_) asm volatile("global_load_dwordx4 %0, %1, off offset:%2" : "=v"(af[s_]) : "v"(ap), "i"(32 * s_) : "memory");
          const float* rp = (const float*)(ws + WS_RQRK) + row * 2 + 1; asm volatile("global_load_dword %0, %1, off" : "=v"(rk) : "v"(rp) : "memory"); }
        bf16* yrow = (bf16*)(ws + WS_KVM) + row * 1024 + 8 * h;
        for (int hf = 0; hf < 2; ++hf) {
            if (hf) { asm volatile("s_waitcnt lgkmcnt(0)" ::: "memory"); __builtin_amdgcn_s_barrier(); asm volatile("" ::: "memory"); }
            for (int i = 0; i < 17; ++i) { const int j = w + 8 * i, byte = 1024 * j + 16 * lane, r_ = byte / KV2_ROW; int cc = (byte % KV2_ROW) >> 4; cc = cc < 16 ? cc : 0;
                __builtin_amdgcn_global_load_lds((const unsigned*)(wbase + (size_t)(512 * hf + r_) * 512 + 256 + cc * 16), (LAS unsigned*)(lds + 1024 * j), 16, 0, 0); }
            asm volatile("s_waitcnt vmcnt(0)" : "+v"(af[0]), "+v"(af[1]), "+v"(af[2]), "+v"(af[3]), "+v"(af[4]), "+v"(af[5]), "+v"(af[6]), "+v"(af[7]), "+v"(rk) :: "memory");
            __builtin_amdgcn_s_barrier(); asm volatile("" ::: "memory");
#pragma unroll 1
            for (int cg = 0; cg < 8; ++cg) {
                f32x16 acc0, acc1;
                const unsigned baddr = (unsigned)(size_t)lds + (unsigned)(cg * 64 * KV2_ROW) + boff;
                bf16x8 b0[2][4], b1[2][4];
#define KV2_LDB(buf_, sb_) do { _Pragma("unroll") for (int q_ = 0; q_ < 4; ++q_) { \
                    asm volatile("ds_read_b128 %0, %1 offset:%2" : "=v"(b0[buf_][q_]) : "v"(baddr), "i"((4 * (sb_) + q_) * 32) : "memory"); \
                    asm volatile("ds_read_b128 %0, %1 offset:%2" : "=v"(b1[buf_][q_]) : "v"(baddr), "i"(32 * KV2_ROW + (4 * (sb_) + q_) * 32) : "memory"); } } while (0)
#define KV2_TIE(buf_) "+v"(b0[buf_][0]), "+v"(b0[buf_][1]), "+v"(b0[buf_][2]), "+v"(b0[buf_][3]), "+v"(b1[buf_][0]), "+v"(b1[buf_][1]), "+v"(b1[buf_][2]), "+v"(b1[buf_][3])
                KV2_LDB(0, 0); KV2_LDB(1, 1);
                asm volatile("s_waitcnt lgkmcnt(8)" : KV2_TIE(0) :: "memory");
#pragma unroll
                for (int q = 0; q < 4; ++q) { acc0 = MFMA32(b0[0][q], af[q], q == 0 ? zero : acc0); acc1 = MFMA32(b1[0][q], af[q], q == 0 ? zero : acc1); }
                asm volatile("s_waitcnt lgkmcnt(0)" : KV2_TIE(1) :: "memory");
#pragma unroll
                for (int q = 0; q < 4; ++q) { acc0 = MFMA32(b0[1][q], af[4 + q], acc0); acc1 = MFMA32(b1[1][q], af[4 + q], acc1); }
#undef KV2_LDB
#undef KV2_TIE
#pragma unroll
                for (int ct = 0; ct < 2; ++ct) {
                    const f32x16& acc = ct ? acc1 : acc0;
                    unsigned d[4][2];
#pragma unroll
                    for (int g = 0; g < 4; ++g) { d[g][0] = pk2(acc[4 * g] * rk, acc[4 * g + 1] * rk); d[g][1] = pk2(acc[4 * g + 2] * rk, acc[4 * g + 3] * rk); }
#pragma unroll
                    for (int pc = 0; pc < 2; ++pc) {
                        const auto s0 = __builtin_amdgcn_permlane32_swap(d[2 * pc][0], d[2 * pc + 1][0], false, false);
                        const auto s1 = __builtin_amdgcn_permlane32_swap(d[2 * pc][1], d[2 * pc + 1][1], false, false);
                        u32x4 o; o[0] = s0[0]; o[1] = s1[0]; o[2] = s0[1]; o[3] = s1[1];
                        *(u32x4*)(yrow + 512 * hf + 64 * cg + 32 * ct + 16 * pc) = o;
                    }
                }
            }
        }
        asm volatile("s_waitcnt vmcnt(0) lgkmcnt(0)" ::: "memory");
        __builtin_amdgcn_s_barrier(); asm volatile("" ::: "memory");
    }
}
DI void p2_up(Frame& F) {
    DenseSched Sq; Sq.init(T, 768, 384, (const bf16*)(F.ws + WS_W_UQ_T), gridDim.x, blockIdx.x);
    { pg::Unit u; for (int i = 0; Sq.next(i, u); ++i) rqrk_panel(F, u.pm);
      for (int k = 0;; ++k) { const int blk = pg::xcd_deal(k, gridDim.x, blockIdx.x, T / 256); if (blk < 0) break; rqrk_panel(F, blk); } }
    asm volatile("s_waitcnt vmcnt(0)" ::: "memory"); __syncthreads();
    { EpiQ E{F.ws}; pg::gemm_phase<EpiQ, DenseSched>(F.lds, (const char*)(F.ws + WS_CQKV), 512, 384, Sq, E); }
    for (int rep = 0; rep < REP_P2B; ++rep) p2b_kv_v2(F);
}
DI void p4_wo(Frame& F) {
    DenseSched S; S.init(T, 1024, 1024, (const bf16*)(F.ws + WS_W_O_T), gridDim.x, blockIdx.x);
    EpiWo E{F.ws, (bf16*)(F.ws + WS_MIXB)};
    pg::gemm_phase<EpiWo, DenseSched>(F.lds, (const char*)(F.ws + WS_Y), 1024, 1024, S, E);
}
DI void p5b_router(Frame& F) {
    DenseSched S; S.init(T, 256, 1024, (const bf16*)(F.ws + WS_W_R), gridDim.x, blockIdx.x);
    EpiRouter E{(float*)(F.ws + WS_LOGITS)};
    pg::gemm_phase<EpiRouter, DenseSched>(F.lds, (const char*)F.out, H1_LD, 1024, S, E);
}
DI void p7_gemm1(Frame& F) {
    build_tab(F);
    const LAS int* tab = (const LAS int*)(F.lds + LDS_TAB);
    Moe1Sched S; S.tab = tab; S.rowinfo = (const u32x2*)(F.ws + WS_ROWINFO); S.W13 = (const char*)(F.ws + WS_W13_T); S.WS13 = (const char*)(F.ws + WS_WS13_T);
    S.nblk = tab[NE]; S.nR = S.nblk * 2; S.nwg = S.nR + (T / 256) * 2; S.G = gridDim.x; S.c = blockIdx.x;
    EpiGate E{(bf16*)(F.ws + WS_HB), (bf16*)(F.ws + WS_HS)};
    pg::gemm_phase<EpiGate, Moe1Sched>(F.lds, (const char*)F.out, H1_LD, 1024, S, E);
}
DI void p8s_shared2(Frame& F) {
    DenseSched S; S.init(T, 1024, 256, (const bf16*)(F.ws + WS_WS2_T), gridDim.x, blockIdx.x);
    EpiShared2 E{(bf16*)F.out + 1024};
    pg::gemm_phase<EpiShared2, DenseSched>(F.lds, (const char*)(F.ws + WS_HS), 256, 256, S, E);
}
DI void p8_gemm2(Frame& F) {
    build_tab(F);
    const LAS int* tab = (const LAS int*)(F.lds + LDS_TAB);
    Moe2Sched S; S.tab = tab; S.W2 = (const char*)(F.ws + WS_W2_T); S.nblk = tab[NE]; S.G = gridDim.x; S.c = blockIdx.x;
    EpiY2 E{(const u32x2*)(F.ws + WS_ROWINFO), (unsigned char*)(F.ws + WS_Y2C)};
    pg::gemm_phase<EpiY2, Moe2Sched>(F.lds, (const char*)(F.ws + WS_HB), 256, 256, S, E);
}
constexpr int G2_ROW = 528, G2_TILE = 64 * G2_ROW;
template <int MODE>
DI void p8_gemm2_v2(Frame& F) {
    build_tab(F);
    const LAS int* tab = (const LAS int*)(F.lds + LDS_TAB);
    const int nblk = tab[NE];
    unsigned char* ws = F.ws;
    int tid = threadIdx.x; asm volatile("" : "+v"(tid));
    const int lane = tid & 63, l31 = lane & 31, h = lane >> 5, w = __builtin_amdgcn_readfirstlane(tid >> 6);
    LAS unsigned char* lds = F.lds;
    const u32x2* ROWI = (const u32x2*)(ws + WS_ROWINFO); unsigned char* Y2 = ws + WS_Y2C;
    unsigned poff[5], pdst[5];
#pragma unroll
    for (int i = 0; i < 5; ++i) { int j = w + 8 * i; if (j >= 33) j -= 8; const int byte = 1024 * j + 16 * lane, row = byte / G2_ROW; int cc = (byte % G2_ROW) >> 4; cc = cc < 32 ? cc : 0;
        poff[i] = (unsigned)(row * 512 + cc * 16); pdst[i] = (unsigned)(1024 * j); }
#define G2_DMA(wbase_, tile_, slot_) do { _Pragma("unroll") for (int i_ = 0; i_ < 5; ++i_) \
        __builtin_amdgcn_global_load_lds((const unsigned*)((wbase_) + (size_t)(tile_) * (64 * 512) + poff[i_]), (LAS unsigned*)(lds + (slot_) * G2_TILE + __builtin_amdgcn_readfirstlane(pdst[i_])), 16, 0, 0); } while (0)
    const unsigned boff = (unsigned)(l31 * G2_ROW + h * 16);
    f32x16 zero;
#pragma unroll
    for (int r = 0; r < 16; ++r) zero[r] = 0.f;
    for (int k = 0;; ++k) {
        const int blk = pg::xcd_deal(k, gridDim.x, blockIdx.x, nblk); if (blk < 0) break;
        const int e = find_expert(tab, blk);
        const char* wbase = (const char*)(ws + WS_W2_T) + (size_t)e * 1024 * 512;
        bf16x8 af[16];
        { const bf16* ap = (const bf16*)(ws + WS_HB) + ((size_t)blk * 256 + 32 * w + l31) * 256 + 8 * h;
#pragma unroll
          for (int s_ = 0; s_ < 16; ++s_) asm volatile("global_load_dwordx4 %0, %1, off offset:%2" : "=v"(af[s_]) : "v"(ap), "i"(32 * s_) : "memory"); }
        u32x2 iw; { const u32x2* ip = ROWI + (unsigned)(blk * 256 + 32 * w + l31); asm volatile("global_load_dwordx2 %0, %1, off" : "=v"(iw) : "v"(ip) : "memory"); }
        G2_DMA(wbase, 0, 0); G2_DMA(wbase, 1, 1);
        asm volatile("s_waitcnt vmcnt(5)" : "+v"(af[0]), "+v"(af[1]), "+v"(af[2]), "+v"(af[3]), "+v"(af[4]), "+v"(af[5]), "+v"(af[6]), "+v"(af[7]), "+v"(af[8]), "+v"(af[9]), "+v"(af[10]), "+v"(af[11]),
                     "+v"(af[12]), "+v"(af[13]), "+v"(af[14]), "+v"(af[15]), "+v"(iw) :: "memory");
        __builtin_amdgcn_s_barrier(); asm volatile("" ::: "memory");
        const int info = (int)iw[0]; const float gsc = __uint_as_float(iw[1]) * Y2_SCALE;
        const int crow0 = ((const LAS int*)(F.lds + LDS_TAB + 1040))[e] + (blk - tab[e]) * 256 + 32 * w + l31;
        unsigned char* yrow = ((info < 0 || MODE >= 1) ? ws + WS_END + 64 * 1024 * w : Y2 + (size_t)crow0 * 1024) + 16 * h;
        int slot = 0;
        for (int t = 0; t < 16; ++t) {
            { int s2 = slot + 2; s2 = s2 >= 3 ? s2 - 3 : s2; const int tn = t + 2 < 16 ? t + 2 : t; G2_DMA(wbase, tn, s2); }
            u32x4 pend0, pend1;
            {
                f32x16 acc0, acc1;
                const unsigned baddr = (unsigned)(size_t)(lds + slot * G2_TILE) + boff;
                bf16x8 b0[2][4], b1[2][4];
#define G2_LDB(buf_, sb_) do { _Pragma("unroll") for (int q_ = 0; q_ < 4; ++q_) { \
                    asm volatile("ds_read_b128 %0, %1 offset:%2" : "=v"(b0[buf_][q_]) : "v"(baddr), "i"((4 * (sb_) + q_) * 32) : "memory"); \
                    asm volatile("ds_read_b128 %0, %1 offset:%2" : "=v"(b1[buf_][q_]) : "v"(baddr), "i"(32 * G2_ROW + (4 * (sb_) + q_) * 32) : "memory"); } } while (0)
#define G2_TIE(buf_) "+v"(b0[buf_][0]), "+v"(b0[buf_][1]), "+v"(b0[buf_][2]), "+v"(b0[buf_][3]), "+v"(b1[buf_][0]), "+v"(b1[buf_][1]), "+v"(b1[buf_][2]), "+v"(b1[buf_][3])
                G2_LDB(0, 0);
#pragma unroll
                for (int sb = 0; sb < 4; ++sb) {
                    if (sb < 3) { if (sb & 1) G2_LDB(0, sb + 1); else G2_LDB(1, sb + 1); }
                    if (sb < 3) { if (sb & 1) asm volatile("s_waitcnt lgkmcnt(8)" : G2_TIE(1) :: "memory"); else asm volatile("s_waitcnt lgkmcnt(8)" : G2_TIE(0) :: "memory"); }
                    else asm volatile("s_waitcnt lgkmcnt(0)" : G2_TIE(1) :: "memory");
#pragma unroll
                    for (int q = 0; q < 4; ++q) { acc0 = MFMA32(b0[sb & 1][q], af[4 * sb + q], (sb == 0 && q == 0) ? zero : acc0); acc1 = MFMA32(b1[sb & 1][q], af[4 * sb + q], (sb == 0 && q == 0) ? zero : acc1); }
                }
#undef G2_LDB
#undef G2_TIE
#pragma unroll
                for (int ct = 0; ct < 2; ++ct) {
                    if (MODE == 5) { if (acc0[0] == 12345.f && acc1[0] == 54321.f) *(float*)(yrow) = 1.f; continue; }
                    const f32x16& acc = ct ? acc1 : acc0;
                    unsigned d[4];
#pragma unroll
                    for (int g = 0; g < 4; ++g) { int w8 = 0; w8 = __builtin_amdgcn_cvt_pk_fp8_f32(acc[4 * g] * gsc, acc[4 * g + 1] * gsc, w8, false); w8 = __builtin_amdgcn_cvt_pk_fp8_f32(acc[4 * g + 2] * gsc, acc[4 * g + 3] * gsc, w8, true); d[g] = (unsigned)w8; }
                    const auto sA = __builtin_amdgcn_permlane32_swap(d[0], d[2], false, false);
                    const auto sB = __builtin_amdgcn_permlane32_swap(d[1], d[3], false, false);
                    u32x4 o; o[0] = sA[0]; o[1] = sA[1]; o[2] = sB[0]; o[3] = sB[1];
                    if (ct) pend1 = o; else pend0 = o;
                }
            }
            asm volatile("s_waitcnt vmcnt(5) lgkmcnt(0)" : "+v"(pend0), "+v"(pend1) :: "memory");
            *(u32x4*)(yrow + 64 * t) = pend0; *(u32x4*)(yrow + 64 * t + 32) = pend1;
            __builtin_amdgcn_s_barrier(); asm volatile("" ::: "memory");
            slot = slot == 2 ? 0 : slot + 1;
        }
        asm volatile("s_waitcnt vmcnt(0)" ::: "memory");
    }
#undef G2_DMA
}

DI void softmax_pv(f32x16& s, float& m, float& l, f32x16& o0, f32x16& o1, const LAS unsigned char* vl, int lane, int h) {
    float mx = s[0];
#pragma unroll
    for (int r = 1; r < 16; ++r) mx = fmaxf(mx, s[r]);
    mx = fmaxf(mx, __shfl_xor(mx, 32));
    const float mn = fmaxf(m, mx);
    const float alpha = __builtin_amdgcn_exp2f(m - mn);
    float ls = 0.f;
#pragma unroll
    for (int r = 0; r < 16; ++r) { s[r] = __builtin_amdgcn_exp2f(s[r] - mn); ls += s[r]; }
    l = l * alpha + ls; m = mn;
#pragma unroll
    for (int r = 0; r < 16; ++r) { o0[r] *= alpha; o1[r] *= alpha; }
    u32x4 p0, p1;
    p0.x = pk2(s[0], s[1]); p0.y = pk2(s[2], s[3]); p0.z = pk2(s[4], s[5]); p0.w = pk2(s[6], s[7]);
    p1.x = pk2(s[8], s[9]); p1.y = pk2(s[10], s[11]); p1.z = pk2(s[12], s[13]); p1.w = pk2(s[14], s[15]);
    const bf16x8 pf0 = __builtin_bit_cast(bf16x8, p0), pf1 = __builtin_bit_cast(bf16x8, p1);
    const int q4 = (lane & 15) >> 2, p4 = lane & 3, blk = (lane >> 4) & 1;
    const LAS unsigned char* vb = vl + (4 * h + q4) * 144 + (16 * blk + 4 * p4) * 2;
#pragma unroll
    for (int sp = 0; sp < 2; ++sp) {
#pragma unroll
        for (int dt = 0; dt < 2; ++dt) {
            const s16x4 lo = tr_read(vb + (16 * sp) * 144 + dt * 64);
            const s16x4 hi = tr_read(vb + (16 * sp + 8) * 144 + dt * 64);
            const bf16x8 vf = __builtin_shufflevector(lo, hi, 0, 1, 2, 3, 4, 5, 6, 7);
            if (dt == 0) o0 = MFMA32(vf, sp ? pf1 : pf0, o0); else o1 = MFMA32(vf, sp ? pf1 : pf0, o1);
        }
    }
}


constexpr int XP_TILES = (NE + 1) * 192;
constexpr int XP_LDS = 3 * (64 * 208 + 64 * 144);
struct Xpose { f32x4 v[16]; const float *w1, *w3, *w2, *s1, *s3, *s2; int next, cur, tick; bool pend; };
DI void xpose_addr(Frame& F, const Xpose& X, int it, const float*& W, int& ldn, int& k0, int& n0, bf16*& dst, int& Kd) {
    const int e = it / 192, q = it % 192, m = q >> 6, qq = q & 63;
    const float* base;
    const float *pw1 = X.w1, *pw3 = X.w3, *pw2 = X.w2, *ps1 = X.s1, *ps3 = X.s3, *ps2 = X.s2;
    asm volatile("" : "+s"(pw1), "+s"(pw3), "+s"(pw2), "+s"(ps1), "+s"(ps3), "+s"(ps2));
    if (e == NE) base = (m == 0) ? ps1 : (m == 1 ? ps3 : ps2);
    else base = ((m == 0) ? pw1 : (m == 1 ? pw3 : pw2)) + (size_t)e * 1024 * 256;
    W = base;
    if (m < 2) { const int kb = qq >> 2, nb = qq & 3; n0 = 64 * nb; k0 = 64 * kb; ldn = 256; Kd = 1024; const int drow = 256 * (n0 >> 7) + 128 * m + (n0 & 127);
        dst = ((e == NE) ? (bf16*)(F.ws + WS_WS13_T) : (bf16*)(F.ws + WS_W13_T) + (size_t)e * 512 * 1024) + (size_t)drow * 1024; }
    else { const int kb = qq >> 4, nb = qq & 15; n0 = 64 * nb; k0 = 64 * kb; ldn = 1024; Kd = 256;
        dst = ((e == NE) ? (bf16*)(F.ws + WS_WS2_T) : (bf16*)(F.ws + WS_W2_T) + (size_t)e * 1024 * 256) + (size_t)n0 * 256; }
}
DI void xpose_issue(Frame& F, Xpose& X) {
    const int lane = (int)threadIdx.x & 63;
    const float* W; int ldn, k0, n0, Kd; bf16* dst; xpose_addr(F, X, X.next, W, ldn, k0, n0, dst, Kd);
    const float* src = W + (size_t)(k0 + (lane >> 4)) * ldn + n0 + 4 * (lane & 15);
#pragma unroll
    for (int i = 0; i < 16; ++i) X.v[i] = *(const f32x4*)(src + (size_t)(4 * i) * ldn);
    X.cur = X.next; X.next += gridDim.x * 8; X.pend = true;
}
DI void xpose_finish(Frame& F, Xpose& X) {
    const int lane = (int)threadIdx.x & 63;
    const float* W; int ldn, k0, n0, Kd; bf16* dst; xpose_addr(F, X, X.cur, W, ldn, k0, n0, dst, Kd);
    const unsigned wa = (unsigned)(size_t)(F.lds + XP_LDS + F.wave * (16 * 68 * 4)) + (unsigned)(((lane >> 4) * 68 + 4 * (lane & 15)) * 4);
    const unsigned ra = (unsigned)(size_t)(F.lds + XP_LDS + F.wave * (16 * 68 * 4)) + 4u * lane;
#pragma unroll
    for (int c = 0; c < 4; ++c) {
#pragma unroll
        for (int i = 0; i < 4; ++i) asm volatile("ds_write_b128 %0, %1 offset:%2" :: "v"(wa), "v"(X.v[4 * c + i]), "i"(4 * i * 68 * 4) : "memory");
        float p[16];
#pragma unroll
        for (int k = 0; k < 16; ++k) asm volatile("ds_read_b32 %0, %1 offset:%2" : "=v"(p[k]) : "v"(ra), "i"(k * 68 * 4) : "memory");
        asm volatile("s_waitcnt lgkmcnt(0)" : "+v"(p[0]), "+v"(p[1]), "+v"(p[2]), "+v"(p[3]), "+v"(p[4]), "+v"(p[5]), "+v"(p[6]), "+v"(p[7]),
                     "+v"(p[8]), "+v"(p[9]), "+v"(p[10]), "+v"(p[11]), "+v"(p[12]), "+v"(p[13]), "+v"(p[14]), "+v"(p[15]) :: "memory");
        u32x4 o0, o1;
        o0.x = pk2(p[0], p[1]); o0.y = pk2(p[2], p[3]); o0.z = pk2(p[4], p[5]); o0.w = pk2(p[6], p[7]);
        o1.x = pk2(p[8], p[9]); o1.y = pk2(p[10], p[11]); o1.z = pk2(p[12], p[13]); o1.w = pk2(p[14], p[15]);
        bf16* d = dst + (size_t)lane * Kd + k0 + 16 * c;
        *(u32x4*)d = o0; *(u32x4*)(d + 8) = o1;
    }
    X.pend = false;
}
template <int EVERY> DI void xpose_step(Frame& F, Xpose& X) {
    if (X.pend) xpose_finish(F, X);
    if (X.next < XP_TILES && (X.tick % EVERY) == 0) xpose_issue(F, X);
    ++X.tick;
    asm volatile("" ::: "memory");
}

constexpr int ATT_VROW = 144;
constexpr float SM_THR = 8.0f;
DI float max3f(float a, float b, float c) { float r; asm("v_max3_f32 %0, %1, %2, %3" : "=v"(r) : "v"(a), "v"(b), "v"(c)); return r; }
DI void softmax_pv64(f32x16& s0, f32x16& s1, float& m, f32x16& negm, bool& seen, float& l, f32x16& o0, f32x16& o1, const unsigned vaddr) {
    s16x4 va0[4], va1[4], vb0[4], vb1[4];
#pragma unroll
    for (int sp = 0; sp < 4; ++sp) {
        asm volatile("ds_read_b64_tr_b16 %0, %1 offset:%2" : "=v"(va0[sp]) : "v"(vaddr), "i"((16 * sp) * ATT_VROW) : "memory");
        asm volatile("ds_read_b64_tr_b16 %0, %1 offset:%2" : "=v"(va1[sp]) : "v"(vaddr), "i"((16 * sp + 8) * ATT_VROW) : "memory");
        asm volatile("ds_read_b64_tr_b16 %0, %1 offset:%2" : "=v"(vb0[sp]) : "v"(vaddr), "i"((16 * sp) * ATT_VROW + 64) : "memory");
        asm volatile("ds_read_b64_tr_b16 %0, %1 offset:%2" : "=v"(vb1[sp]) : "v"(vaddr), "i"((16 * sp + 8) * ATT_VROW + 64) : "memory"); }
    float a = max3f(s0[0], s0[1], s1[0]), bq = max3f(s0[2], s0[3], s1[1]); a = max3f(a, s1[2], s1[3]);
#pragma unroll
    for (int r = 4; r < 16; r += 4) { a = max3f(a, s0[r], s0[r + 1]); bq = max3f(bq, s0[r + 2], s0[r + 3]); a = max3f(a, s1[r], s1[r + 1]); bq = max3f(bq, s1[r + 2], s1[r + 3]); }
    float mx = fmaxf(a, bq);
    { auto rr = __builtin_amdgcn_permlane32_swap(__float_as_uint(mx), __float_as_uint(mx), false, false); mx = fmaxf(__uint_as_float(rr[0]), __uint_as_float(rr[1])); }
    const bool valid = mx > -1e29f;
    const float dl = seen ? (mx > SM_THR ? mx : 0.f) : (valid ? mx : 0.f);
    seen = seen || valid;
    if (__any(dl != 0.f)) {
        m += dl;
#pragma unroll
        for (int r = 0; r < 16; ++r) { s0[r] -= dl; s1[r] -= dl; }
        const float alpha = __builtin_amdgcn_exp2f(-fmaxf(dl, 0.f));
        l *= alpha;
#pragma unroll
        for (int r = 0; r < 16; ++r) { o0[r] *= alpha; o1[r] *= alpha; negm[r] = -m; }
    }
#pragma unroll
    for (int r = 0; r < 16; ++r) { s0[r] = __builtin_amdgcn_exp2f(s0[r]); s1[r] = __builtin_amdgcn_exp2f(s1[r]); }
    f32x2 acc2 = {0.f, 0.f};
#pragma unroll
    for (int r = 0; r < 16; r += 2) { acc2 = acc2 + (f32x2){s0[r], s0[r + 1]}; acc2 = acc2 + (f32x2){s1[r], s1[r + 1]}; }
    l += acc2[0] + acc2[1];
    u32x4 pw[4];
    pw[0].x = pk2(s0[0], s0[1]); pw[0].y = pk2(s0[2], s0[3]); pw[0].z = pk2(s0[4], s0[5]); pw[0].w = pk2(s0[6], s0[7]);
    pw[1].x = pk2(s0[8], s0[9]); pw[1].y = pk2(s0[10], s0[11]); pw[1].z = pk2(s0[12], s0[13]); pw[1].w = pk2(s0[14], s0[15]);
    pw[2].x = pk2(s1[0], s1[1]); pw[2].y = pk2(s1[2], s1[3]); pw[2].z = pk2(s1[4], s1[5]); pw[2].w = pk2(s1[6], s1[7]);
    pw[3].x = pk2(s1[8], s1[9]); pw[3].y = pk2(s1[10], s1[11]); pw[3].z = pk2(s1[12], s1[13]); pw[3].w = pk2(s1[14], s1[15]);
    asm volatile("s_waitcnt lgkmcnt(0)" : "+v"(va0[0]), "+v"(va1[0]), "+v"(vb0[0]), "+v"(vb1[0]), "+v"(va0[1]), "+v"(va1[1]), "+v"(vb0[1]), "+v"(vb1[1]),
                 "+v"(va0[2]), "+v"(va1[2]), "+v"(vb0[2]), "+v"(vb1[2]), "+v"(va0[3]), "+v"(va1[3]), "+v"(vb0[3]), "+v"(vb1[3]) :: "memory");
#pragma unroll
    for (int sp = 0; sp < 4; ++sp) { const bf16x8 pf = __builtin_bit_cast(bf16x8, pw[sp]);
        o0 = MFMA32(__builtin_shufflevector(va0[sp], va1[sp], 0, 1, 2, 3, 4, 5, 6, 7), pf, o0);
        o1 = MFMA32(__builtin_shufflevector(vb0[sp], vb1[sp], 0, 1, 2, 3, 4, 5, 6, 7), pf, o1); }
}

constexpr int MLA_KROW = 208, MLA_VROW = ATT_VROW;
constexpr int MLA_KBYTES = 64 * MLA_KROW, MLA_VBYTES = 64 * MLA_VROW, MLA_STAGE = MLA_KBYTES + MLA_VBYTES;
DI void mla_unit(Frame& F, int b, int hh, int qb, Xpose& X) {
    unsigned char* ws = F.ws;
    int tid = threadIdx.x; asm volatile("" : "+v"(tid));
    const int lane = tid & 63, l31 = lane & 31, h = lane >> 5, w = __builtin_amdgcn_readfirstlane(tid >> 6);
    const bf16* QM = (const bf16*)(ws + WS_QM);
    LAS unsigned char* lds = F.lds;
    const size_t rb = (size_t)b * SEQ;
    const int NT = 4 * (qb + 1), tdiag = 4 * qb + (w >> 1);
    const char* src[3]; unsigned stride[3], dst[3];
#pragma unroll
    for (int i = 0; i < 3; ++i) {
        int j = w + 8 * i; if (j >= 22) j -= 8;
        const char* p; unsigned st;
        if (j < 13) { const int byte = 1024 * j + 16 * lane, row = byte / MLA_KROW, cc = (byte % MLA_KROW) >> 4;
            if (cc >= 8 && cc < 12) { p = (const char*)(ws + WS_KPE) + ((rb + row) * 32 + (cc - 8) * 8) * 2; st = 64 * 32 * 2; }
            else { p = (const char*)(ws + WS_KVM) + ((rb + row) * 1024 + hh * 128 + (cc < 8 ? cc : 0) * 8) * 2; st = 64 * 1024 * 2; } }
        else { const int byte = 1024 * (j - 13) + 16 * lane, row = byte / MLA_VROW, cc = (byte % MLA_VROW) >> 4;
            p = (const char*)(ws + WS_KVM) + ((rb + row) * 1024 + hh * 128 + 64 + (cc < 8 ? cc : 0) * 8) * 2; st = 64 * 1024 * 2; }
        src[i] = p; stride[i] = st; dst[i] = (unsigned)(1024 * j);
    }
#define MLA_DMA(tile_, slot_) do { _Pragma("unroll") for (int i_ = 0; i_ < 3; ++i_) \
        __builtin_amdgcn_global_load_lds((const unsigned*)(src[i_] + (size_t)(tile_) * stride[i_]), (LAS unsigned*)(lds + (slot_) * MLA_STAGE + __builtin_amdgcn_readfirstlane(dst[i_])), 16, 0, 0); } while (0)
    constexpr int NS = 3;
#pragma unroll
    for (int i = 0; i < NS - 1; ++i) MLA_DMA((i < NT ? i : NT - 1), i);
    const size_t t0 = rb + qb * 256 + w * 32;
    bf16x8 qf[6];
    { const bf16* qp = QM + (t0 + l31) * 768 + hh * 96 + 8 * h;
#pragma unroll
      for (int s = 0; s < 6; ++s) qf[s] = *(const bf16x8*)(qp + 16 * s); }
    f32x16 o0, o1;
#pragma unroll
    for (int r = 0; r < 16; ++r) { o0[r] = 0.f; o1[r] = 0.f; }
    float m = 0.f, l = 0.f; f32x16 negm; bool seen = false;
#pragma unroll
    for (int r = 0; r < 16; ++r) negm[r] = 0.f;
    const int q4 = (lane & 15) >> 2, p4 = lane & 3, blk = (lane >> 4) & 1;
    const int koff = l31 * MLA_KROW + h * 16, voff = MLA_KBYTES + (4 * h + q4) * MLA_VROW + (16 * blk + 4 * p4) * 2;
    asm volatile("s_waitcnt vmcnt(0)" : "+v"(qf[0]), "+v"(qf[1]), "+v"(qf[2]), "+v"(qf[3]), "+v"(qf[4]), "+v"(qf[5]) :: "memory");
    __builtin_amdgcn_s_barrier(); asm volatile("" ::: "memory");
    int slot = 0;
    if (w >= 4) __builtin_amdgcn_s_setprio(1);
    for (int t = 0; t < NT; ++t) {
        const int cb = slot * MLA_STAGE;
        xpose_step<10>(F, X);
        { int s2 = slot + NS - 1; s2 = s2 >= NS ? s2 - NS : s2; const int tn = (t + NS - 1 < NT) ? t + NS - 1 : t; MLA_DMA(tn, s2); }
        if (t <= tdiag) {
            f32x16 s0, s1;
            const unsigned kaddr = (unsigned)(size_t)(lds + cb + koff);
            {
                bf16x8 ka[6], kb[6];
#define MLA_KRD(ks_) do { asm volatile("ds_read_b128 %0, %1 offset:%2" : "=v"(ka[ks_]) : "v"(kaddr), "i"((ks_) * 32) : "memory"); \
                          asm volatile("ds_read_b128 %0, %1 offset:%2" : "=v"(kb[ks_]) : "v"(kaddr), "i"(32 * MLA_KROW + (ks_) * 32) : "memory"); } while (0)
                MLA_KRD(0); MLA_KRD(1); MLA_KRD(2); MLA_KRD(3);
                asm volatile("s_waitcnt lgkmcnt(4)" : "+v"(ka[0]), "+v"(kb[0]), "+v"(ka[1]), "+v"(kb[1]) :: "memory");
                s0 = MFMA32(ka[0], qf[0], negm); s1 = MFMA32(kb[0], qf[0], negm);
                s0 = MFMA32(ka[1], qf[1], s0); s1 = MFMA32(kb[1], qf[1], s1);
                MLA_KRD(4); MLA_KRD(5);
                asm volatile("s_waitcnt lgkmcnt(4)" : "+v"(ka[2]), "+v"(kb[2]), "+v"(ka[3]), "+v"(kb[3]) :: "memory");
                s0 = MFMA32(ka[2], qf[2], s0); s1 = MFMA32(kb[2], qf[2], s1);
                s0 = MFMA32(ka[3], qf[3], s0); s1 = MFMA32(kb[3], qf[3], s1);
                __builtin_amdgcn_sched_barrier(0);
                asm volatile("s_waitcnt lgkmcnt(0)" : "+v"(ka[4]), "+v"(kb[4]), "+v"(ka[5]), "+v"(kb[5]) :: "memory");
                s0 = MFMA32(ka[4], qf[4], s0); s1 = MFMA32(kb[4], qf[4], s1);
                s0 = MFMA32(ka[5], qf[5], s0); s1 = MFMA32(kb[5], qf[5], s1);
#undef MLA_KRD
            }
            if (t == tdiag) {
                if (w & 1) {
#pragma unroll
                    for (int r = 0; r < 16; ++r) if (crow(r, h) > l31) s1[r] = NEG;
                } else {
#pragma unroll
                    for (int r = 0; r < 16; ++r) { if (crow(r, h) > l31) s0[r] = NEG; s1[r] = NEG; }
                }
            }
            softmax_pv64(s0, s1, m, negm, seen, l, o0, o1, (unsigned)(size_t)(lds + cb + voff));
        }
        asm volatile("s_waitcnt vmcnt(3) lgkmcnt(0)" ::: "memory");
        __builtin_amdgcn_s_barrier(); asm volatile("" ::: "memory");
        slot = slot == NS - 1 ? 0 : slot + 1;
    }
    __builtin_amdgcn_s_setprio(0);
    asm volatile("s_waitcnt vmcnt(0)" ::: "memory");
#undef MLA_DMA
    const float lt = l + __shfl_xor(l, 32); const float inv = 1.0f / lt;
    float ssq = 0.f;
#pragma unroll
    for (int r = 0; r < 16; ++r) { o0[r] *= inv; o1[r] *= inv; ssq += o0[r] * o0[r] + o1[r] * o1[r]; }
    ssq += __shfl_xor(ssq, 32);
    bf16* yp = (bf16*)(ws + WS_Y) + (t0 + l31) * 1024 + 512 + hh * 64;
    store_tile_bf16(yp, o0, h); store_tile_bf16(yp + 32, o1, h);
    if (h == 0) ((float*)(ws + WS_SSQO))[(t0 + l31) * 16 + 8 + hh] = ssq;
}
DI void mla_phase(Frame& F, Xpose& X) {
    const int G = gridDim.x, c = blockIdx.x;
    if (G == 256) {
        const int xcd = c & 7, slot = c >> 3, p = slot >> 3, j = slot & 7;
        for (int r = 0; r < 4; ++r) { const int bh = r * 32 + xcd * 4 + p; mla_unit(F, bh >> 3, bh & 7, 15 - j, X); mla_unit(F, bh >> 3, bh & 7, j, X); }
    } else {
        for (int u = c; u < NBATCH * 8 * 16; u += G) mla_unit(F, (u >> 4) >> 3, (u >> 4) & 7, 15 - (u & 15), X);
    }
}

constexpr int SWA_KROW = 144, SWA_KBYTES = 64 * SWA_KROW, SWA_STAGE = SWA_KBYTES + 64 * ATT_VROW;
DI void swa_unit(Frame& F, int b, int hh, int pt, int res, int qb) {
    unsigned char* ws = F.ws;
    int tid = threadIdx.x; asm volatile("" : "+v"(tid));
    const int lane = tid & 63, l31 = lane & 31, h = lane >> 5, w = __builtin_amdgcn_readfirstlane(tid >> 6);
    LAS unsigned char* lds = F.lds;
    const int dsh = 2 * pt;
    const size_t tb = (size_t)b * SEQ + res;
    const int j0 = qb * 256, qlo = j0 + 32 * w;
    const int tlo = j0 >= 128 ? (j0 - 128) >> 6 : 0, NT = ((j0 + 255) >> 6) - tlo + 1;
    int wfirst = (qlo - 128) >> 6; wfirst = wfirst < tlo ? tlo : wfirst; const int wlast = (qlo + 31) >> 6;
    const char* src[3]; unsigned dst[3];
    const size_t tstride = ((size_t)64 << dsh) * 512 * 2;
#pragma unroll
    for (int i = 0; i < 3; ++i) {
        int j = w + 8 * i; if (j >= 18) j -= 8;
        const int jj = j < 9 ? j : j - 9, byte = 1024 * jj + 16 * lane, row = byte / SWA_KROW; int cc = (byte % SWA_KROW) >> 4; cc = cc < 8 ? cc : 0;
        src[i] = (const char*)(ws + (j < 9 ? WS_KD : WS_VD)) + ((tb + ((size_t)(tlo * 64 + row) << dsh)) * 512 + hh * 64 + cc * 8) * 2; dst[i] = (unsigned)(1024 * j);
    }
#define SWA_DMA(tile_, slot_) do { _Pragma("unroll") for (int i_ = 0; i_ < 3; ++i_) \
        __builtin_amdgcn_global_load_lds((const unsigned*)(src[i_] + (size_t)(tile_) * tstride), (LAS unsigned*)(lds + (slot_) * SWA_STAGE + __builtin_amdgcn_readfirstlane(dst[i_])), 16, 0, 0); } while (0)
    SWA_DMA(0, 0); SWA_DMA(1, 1);
    const size_t tq = tb + ((size_t)(qlo + l31) << dsh);
    bf16x8 qf[4];
    { const bf16* qp = (const bf16*)(ws + WS_QD) + tq * 512 + hh * 64 + 8 * h;
#pragma unroll
      for (int s_ = 0; s_ < 4; ++s_) qf[s_] = *(const bf16x8*)(qp + 16 * s_); }
    f32x16 o0, o1;
#pragma unroll
    for (int r = 0; r < 16; ++r) { o0[r] = 0.f; o1[r] = 0.f; }
    float m = 0.f, l = 0.f; f32x16 negm; bool seen = false;
#pragma unroll
    for (int r = 0; r < 16; ++r) negm[r] = 0.f;
    const int q4 = (lane & 15) >> 2, p4 = lane & 3, blk = (lane >> 4) & 1;
    const int koff = l31 * SWA_KROW + h * 16, voff = SWA_KBYTES + (4 * h + q4) * ATT_VROW + (16 * blk + 4 * p4) * 2;
    asm volatile("s_waitcnt vmcnt(0)" : "+v"(qf[0]), "+v"(qf[1]), "+v"(qf[2]), "+v"(qf[3]) :: "memory");
    __builtin_amdgcn_s_barrier(); asm volatile("" ::: "memory");
    int slot = 0;
    for (int t = 0; t < NT; ++t) {
        const int cb = slot * SWA_STAGE, T = tlo + t;
        { int s2 = slot + 2; s2 = s2 >= 3 ? s2 - 3 : s2; const int tn = (t + 2 < NT) ? t + 2 : t; SWA_DMA(tn, s2); }
        if (T >= wfirst && T <= wlast) {
            f32x16 s0, s1;
            const unsigned kaddr = (unsigned)(size_t)(lds + cb + koff);
            {
                bf16x8 k0[4], k1[4];
#pragma unroll
                for (int ks = 0; ks < 4; ++ks) {
                    asm volatile("ds_read_b128 %0, %1 offset:%2" : "=v"(k0[ks]) : "v"(kaddr), "i"(ks * 32) : "memory");
                    asm volatile("ds_read_b128 %0, %1 offset:%2" : "=v"(k1[ks]) : "v"(kaddr), "i"(32 * SWA_KROW + ks * 32) : "memory"); }
                asm volatile("s_waitcnt lgkmcnt(0)" : "+v"(k0[0]), "+v"(k0[1]), "+v"(k0[2]), "+v"(k0[3]), "+v"(k1[0]), "+v"(k1[1]), "+v"(k1[2]), "+v"(k1[3]) :: "memory");
#pragma unroll
                for (int ks = 0; ks < 4; ++ks) {
                    if (ks == 0) { s0 = MFMA32(k0[0], qf[0], negm); s1 = MFMA32(k1[0], qf[0], negm); }
                    else { s0 = MFMA32(k0[ks], qf[ks], s0); s1 = MFMA32(k1[ks], qf[ks], s1); } }
            }
            if (T == wfirst || T == wlast) {
                const int dq = qlo + l31 - 64 * T;
#pragma unroll
                for (int r = 0; r < 16; ++r) { const int k0_ = crow(r, h), k1_ = 32 + crow(r, h);
                    if (k0_ > dq || k0_ < dq - 128) s0[r] = NEG;
                    if (k1_ > dq || k1_ < dq - 128) s1[r] = NEG; }
            }
            softmax_pv64(s0, s1, m, negm, seen, l, o0, o1, (unsigned)(size_t)(lds + cb + voff));
        }
        asm volatile("s_waitcnt vmcnt(3) lgkmcnt(0)" ::: "memory");
        __builtin_amdgcn_s_barrier(); asm volatile("" ::: "memory");
        slot = slot == 2 ? 0 : slot + 1;
    }
    asm volatile("s_waitcnt vmcnt(0)" ::: "memory");
#undef SWA_DMA
    const float lt = l + __shfl_xor(l, 32); const float inv = 1.0f / lt;
#pragma unroll
    for (int r = 0; r < 16; ++r) { o0[r] *= inv; o1[r] *= inv; }
    bf16* op = (bf16*)((unsigned char*)F.out + DO_ODP) + ((size_t)pt * T + tq) * 512 + hh * 64;
    store_tile_bf16(op, o0, h); store_tile_bf16(op + 32, o1, h);
    if (h == 0) { f32x2 ml = {m, lt}; *(f32x2*)((float*)((unsigned char*)F.out + DO_MLP) + (((size_t)pt * T + tq) * 8 + hh) * 2) = ml; }
}
constexpr int SWS_TILE = SWA_STAGE, SWS_STAGE = 2 * SWS_TILE;
struct SwaUnit { size_t tb; int j0, dsh, hh, pt; };
DI SwaUnit swa_decode(int u) {
    SwaUnit r; const int bh = u / 48, rem = u % 48; r.pt = rem >> 4; const int g = rem & 15, nblk = 16 >> (2 * r.pt);
    r.dsh = 2 * r.pt; r.hh = bh & 7; r.tb = (size_t)(bh >> 3) * SEQ + g / nblk; r.j0 = (g % nblk) * 256; return r;
}
DI int swa_uidx(int c, int n, int G) {
    if (G != 256) return c + n * G;
    const int xcd = c & 7, slot = c >> 3, r = n / 3, i = n - 3 * r, q = slot * 3 + i;
    return (xcd * 16 + 2 * r + (q >= 48 ? 1 : 0)) * 48 + (q >= 48 ? q - 48 : q);
}
DI void swa_stream(Frame& F) {
    unsigned char* ws = F.ws;
    int tid = threadIdx.x; asm volatile("" : "+v"(tid));
    const int lane = tid & 63, l31 = lane & 31, h = lane >> 5, w = __builtin_amdgcn_readfirstlane(tid >> 6), p8 = w >> 1;
    LAS unsigned char* lds = F.lds;
    const int G = gridDim.x, c = blockIdx.x;
    const int NUT = NBATCH * 8 * 48, NU = (NUT - c + G - 1) / G;
    if (NU <= 0) return;
    int prow[5], pcc[5]; unsigned pdst[5]; bool pv[5], pback[5];
#pragma unroll
    for (int i = 0; i < 5; ++i) { int j = w + 8 * i; if (j >= 36) j -= 8; pback[i] = j >= 18; const int jj = j % 18; pv[i] = jj >= 9;
        const int byte = 1024 * (jj % 9) + 16 * lane; prow[i] = byte / SWA_KROW; const int cc = (byte % SWA_KROW) >> 4; pcc[i] = cc < 8 ? cc : 0; pdst[i] = (unsigned)(1024 * j); }
    SwaUnit fu = swa_decode(swa_uidx(c, 0, G)), bu = fu;
#define SWS_DMA(g_, slot_) do { const int a_ = (g_) / 3, r_ = (g_) - 3 * a_; \
        if (r_ == 0 && a_ > 0) { bu = fu; fu = swa_decode(swa_uidx(c, (a_ < NU ? a_ : NU - 1), G)); } \
        _Pragma("unroll") for (int i_ = 0; i_ < 5; ++i_) { const bool bk_ = pback[i_]; \
            int pos_ = (bk_ ? bu.j0 : fu.j0) - 128 + 64 * (bk_ ? r_ + 3 : r_) + prow[i_]; pos_ = pos_ < 0 ? 0 : pos_; \
            const char* src_ = (const char*)(ws + (pv[i_] ? WS_VD : WS_KD)) + (((bk_ ? bu.tb : fu.tb) + ((size_t)pos_ << (bk_ ? bu.dsh : fu.dsh))) * 512 + (bk_ ? bu.hh : fu.hh) * 64 + pcc[i_] * 8) * 2; \
            __builtin_amdgcn_global_load_lds((const unsigned*)src_, (LAS unsigned*)(lds + (slot_) * SWS_STAGE + __builtin_amdgcn_readfirstlane(pdst[i_])), 16, 0, 0); } } while (0)
    const int q4 = (lane & 15) >> 2, p4 = lane & 3, blk = (lane >> 4) & 1;
    const int koff = l31 * SWA_KROW + h * 16, voff = SWA_KBYTES + (4 * h + q4) * ATT_VROW + (16 * blk + 4 * p4) * 2;
    bf16x8 qf[4], qfn[4];
    { const SwaUnit u0 = swa_decode(swa_uidx(c, 0, G)); const bf16* qp = (const bf16*)(ws + WS_QD) + (u0.tb + ((size_t)(u0.j0 + 32 * w + l31) << u0.dsh)) * 512 + u0.hh * 64 + 8 * h;
#pragma unroll
      for (int s_ = 0; s_ < 4; ++s_) asm volatile("global_load_dwordx4 %0, %1, off offset:%2" : "=v"(qfn[s_]) : "v"(qp), "i"(32 * s_) : "memory"); }
    SWS_DMA(0, 0); SWS_DMA(1, 1);
    asm volatile("s_waitcnt vmcnt(5)" : "+v"(qfn[0]), "+v"(qfn[1]), "+v"(qfn[2]), "+v"(qfn[3]) :: "memory");
    __builtin_amdgcn_s_barrier(); asm volatile("" ::: "memory");
    f32x16 o0, o1, negm; float m = 0.f, l = 0.f; bool seen = false;
#pragma unroll
    for (int r = 0; r < 16; ++r) { o0[r] = 0.f; o1[r] = 0.f; negm[r] = 0.f; }
#pragma unroll
    for (int s_ = 0; s_ < 4; ++s_) qf[s_] = qfn[s_];
    SwaUnit cu = swa_decode(swa_uidx(c, 0, G));
    const int NSTEP = 3 * NU + 3;
    int slot = 0;
    if (w >= 4) __builtin_amdgcn_s_setprio(1);
    for (int g = 0; g < NSTEP; ++g) {
        const int cb = slot * SWS_STAGE;
        const int q = g - p8;
        if (q >= 0 && q < 3 * NU) { const int n = q / 3, r = q - 3 * n;
            if (r == 1 && n + 1 < NU) {
                const SwaUnit nu = swa_decode(swa_uidx(c, n + 1, G)); const bf16* qp = (const bf16*)(ws + WS_QD) + (nu.tb + ((size_t)(nu.j0 + 32 * w + l31) << nu.dsh)) * 512 + nu.hh * 64 + 8 * h;
#pragma unroll
                for (int s_ = 0; s_ < 4; ++s_) asm volatile("global_load_dwordx4 %0, %1, off offset:%2" : "=v"(qfn[s_]) : "v"(qp), "i"(32 * s_) : "memory");
            } }
        { int s2 = slot + 2; s2 = s2 >= 3 ? s2 - 3 : s2; const int gn = g + 2 < NSTEP ? g + 2 : g; SWS_DMA(gn, s2); }
        if (q >= 0 && q < 3 * NU) {
            const int n = q / 3, r = q - 3 * n, ti = p8 + r;
            if (r == 0) {
                cu = swa_decode(swa_uidx(c, n, G));
#pragma unroll
                for (int s_ = 0; s_ < 4; ++s_) qf[s_] = qfn[s_];
#pragma unroll
                for (int rr = 0; rr < 16; ++rr) { o0[rr] = 0.f; o1[rr] = 0.f; negm[rr] = 0.f; }
                m = 0.f; l = 0.f; seen = false;
            }
            const int tbase = cb + (ti >= 3 ? SWS_TILE : 0);
            f32x16 s0, s1;
            const unsigned kaddr = (unsigned)(size_t)(lds + tbase + koff);
            {
                bf16x8 k0[4], k1[4];
#pragma unroll
                for (int ks = 0; ks < 4; ++ks) {
                    asm volatile("ds_read_b128 %0, %1 offset:%2" : "=v"(k0[ks]) : "v"(kaddr), "i"(ks * 32) : "memory");
                    asm volatile("ds_read_b128 %0, %1 offset:%2" : "=v"(k1[ks]) : "v"(kaddr), "i"(32 * SWA_KROW + ks * 32) : "memory"); }
                asm volatile("s_waitcnt lgkmcnt(0)" : "+v"(k0[0]), "+v"(k0[1]), "+v"(k0[2]), "+v"(k0[3]), "+v"(k1[0]), "+v"(k1[1]), "+v"(k1[2]), "+v"(k1[3]) :: "memory");
#pragma unroll
                for (int ks = 0; ks < 4; ++ks) {
                    if (ks == 0) { s0 = MFMA32(k0[0], qf[0], negm); s1 = MFMA32(k1[0], qf[0], negm); }
                    else { s0 = MFMA32(k0[ks], qf[ks], s0); s1 = MFMA32(k1[ks], qf[ks], s1); } }
            }
            if (r != 1 || cu.j0 == 0) {
                const int dq = 32 * w + l31 + 128 - 64 * ti;
                int lo = dq - 128; const int kmin = 128 - cu.j0 - 64 * ti; lo = lo > kmin ? lo : kmin;
                if (r == 2) {
#pragma unroll
                    for (int rr = 0; rr < 16; ++rr) { if (crow(rr, h) > dq) s0[rr] = NEG; if (32 + crow(rr, h) > dq) s1[rr] = NEG; }
                } else {
#pragma unroll
                    for (int rr = 0; rr < 16; ++rr) { if (crow(rr, h) < lo) s0[rr] = NEG; if (32 + crow(rr, h) < lo) s1[rr] = NEG; }
                }
            }
            softmax_pv64(s0, s1, m, negm, seen, l, o0, o1, (unsigned)(size_t)(lds + tbase + voff));
            if (r == 2) {
                const float lt = l + __shfl_xor(l, 32); const float inv = 1.0f / lt;
#pragma unroll
                for (int rr = 0; rr < 16; ++rr) { o0[rr] *= inv; o1[rr] *= inv; }
                const size_t tq = cu.tb + ((size_t)(cu.j0 + 32 * w + l31) << cu.dsh);
                bf16* op = (bf16*)((unsigned char*)F.out + DO_ODP) + ((size_t)cu.pt * T + tq) * 512 + cu.hh * 64;
                store_tile_bf16(op, o0, h); store_tile_bf16(op + 32, o1, h);
                if (h == 0) { f32x2 ml = {m, lt}; *(f32x2*)((float*)((unsigned char*)F.out + DO_MLP) + (((size_t)cu.pt * T + tq) * 8 + cu.hh) * 2) = ml; }
            }
        }
        asm volatile("" ::: "memory");
        asm volatile("s_waitcnt vmcnt(5) lgkmcnt(0)" : "+v"(qfn[0]), "+v"(qfn[1]), "+v"(qfn[2]), "+v"(qfn[3]) :: "memory");
        __builtin_amdgcn_s_barrier(); asm volatile("" ::: "memory");
        slot = slot == 2 ? 0 : slot + 1;
    }
    __builtin_amdgcn_s_setprio(0);
    asm volatile("s_waitcnt vmcnt(0)" ::: "memory");
#undef SWS_DMA
}

DI void swa_phase(Frame& F) {
    for (int u = blockIdx.x; u < NBATCH * 8 * 48; u += gridDim.x) {
        const int bh = u / 48, rem = u % 48, pt = rem >> 4, g = rem & 15;
        const int nblk = 16 >> (2 * pt);
        swa_unit(F, bh >> 3, bh & 7, pt, g / nblk, g % nblk);
    }
}

DI void dil_phase(Frame& F) {
    unsigned char* ws = F.ws;
    const int h = (((int)threadIdx.x >> 5) & 1), l31 = ((int)threadIdx.x & 31), lane = ((int)threadIdx.x & 63);
    LAS unsigned char* vl = F.lds + LDS_WSCR + F.wave * 16384;
    {
    const bf16* QD = (const bf16*)(ws + WS_QD); const bf16* KD = (const bf16*)(ws + WS_KD); const bf16* VD = (const bf16*)(ws + WS_VD);
    bf16* ODP = (bf16*)((unsigned char*)F.out + DO_ODP); float* MLP = (float*)((unsigned char*)F.out + DO_MLP);
    constexpr int NTASK = NBATCH * 8 * 3 * 128;
#define DIL_DECODE(task_, tb_, j0_, dsh_, hh_, pt_) do { const int g_ = (task_) & 127; pt_ = ((task_) >> 7) % 3; const int bh_ = (task_) / 384; hh_ = bh_ & 7; dsh_ = 2 * pt_; \
        const int gpr_ = (SEQ >> dsh_) >> 5; const int res_ = g_ / gpr_; j0_ = (g_ % gpr_) * 32; tb_ = (size_t)(bh_ >> 3) * SEQ + res_; } while (0)
#define DIL_LOADQ(dst_, tb_, j0_, dsh_, hh_) do { const bf16* qp_ = QD + (tb_ + ((size_t)((j0_) + l31) << (dsh_))) * 512 + (hh_) * 64 + 8 * h; \
        _Pragma("unroll") for (int s_ = 0; s_ < 4; ++s_) dst_[s_] = *(const bf16x8*)(qp_ + 16 * s_); } while (0)
#define DIL_LOADKV(kd_, vd_, tb_, j0_, dsh_, hh_, kt_) do { const int pb_ = (j0_) + 32 * (kt_); \
        { int pos_ = pb_ + l31; pos_ = pos_ < 0 ? 0 : pos_; const bf16* kp_ = KD + (tb_ + ((size_t)pos_ << (dsh_))) * 512 + (hh_) * 64 + 8 * h; \
          _Pragma("unroll") for (int s_ = 0; s_ < 4; ++s_) kd_[s_] = *(const bf16x8*)(kp_ + 16 * s_); } \
        _Pragma("unroll") for (int i_ = 0; i_ < 4; ++i_) { const int c_ = lane + 64 * i_; int pos_ = pb_ + (c_ >> 3); pos_ = pos_ < 0 ? 0 : pos_; \
          vd_[i_] = *(const u32x4*)(VD + (tb_ + ((size_t)pos_ << (dsh_))) * 512 + (hh_) * 64 + (c_ & 7) * 8); } } while (0)
    int task = F.gw;
    if (task < NTASK) {
        size_t tb, ntb = 0; int j0, dsh, hh, pt, nj0 = 0, ndsh = 0, nhh = 0, npt = 0;
        DIL_DECODE(task, tb, j0, dsh, hh, pt);
        int kt = -(j0 >> 5); kt = kt < -4 ? -4 : kt;
        bf16x8 qf[4], qfn[4], kf[4], kfn[4]; u32x4 vv[4], vvn[4];
        DIL_LOADQ(qf, tb, j0, dsh, hh);
#pragma unroll
        for (int s_ = 0; s_ < 4; ++s_) qfn[s_] = qf[s_];
        DIL_LOADKV(kfn, vvn, tb, j0, dsh, hh, kt);
        f32x16 o0, o1;
#pragma unroll
        for (int r = 0; r < 16; ++r) { o0[r] = 0.f; o1[r] = 0.f; }
        float m = NEG, l = 0.f;
        for (;;) {
#pragma unroll
            for (int i = 0; i < 4; ++i) { kf[i] = kfn[i]; vv[i] = vvn[i]; }
#pragma unroll
            for (int i = 0; i < 4; ++i) { const int c = lane + 64 * i; *(LAS u32x4*)(vl + (c >> 3) * 144 + (c & 7) * 16) = vv[i]; }
            const bool last_tile = (kt == 0);
            int nkt = kt + 1, ntask = task; bool has_next = true;
            if (last_tile) {
                ntask = task + F.ngw; has_next = ntask < NTASK;
                if (has_next) { DIL_DECODE(ntask, ntb, nj0, ndsh, nhh, npt); nkt = -(nj0 >> 5); nkt = nkt < -4 ? -4 : nkt; DIL_LOADQ(qfn, ntb, nj0, ndsh, nhh); DIL_LOADKV(kfn, vvn, ntb, nj0, ndsh, nhh, nkt); }
            } else { DIL_LOADKV(kfn, vvn, tb, j0, dsh, hh, nkt); }
            f32x16 sc;
#pragma unroll
            for (int r = 0; r < 16; ++r) sc[r] = 0.f;
#pragma unroll
            for (int ss = 0; ss < 4; ++ss) sc = MFMA32(kf[ss], qf[ss], sc);
            { const int pb = j0 + 32 * kt;
#pragma unroll
              for (int r = 0; r < 16; ++r) { const int kk = crow(r, h);
                bool ok = (pb + kk) >= 0;
                if (kt == -4) ok = ok && (kk >= l31);
                if (kt == 0) ok = ok && (kk <= l31);
                if (!ok) sc[r] = NEG; } }
            softmax_pv(sc, m, l, o0, o1, vl, lane, h);
            if (last_tile) {
                const float lt = l + __shfl_xor(l, 32); const float inv = 1.0f / lt;
#pragma unroll
                for (int r = 0; r < 16; ++r) { o0[r] *= inv; o1[r] *= inv; }
                const size_t tq = tb + ((size_t)(j0 + l31) << dsh);
                bf16* op = ODP + ((size_t)pt * T + tq) * 512 + hh * 64;
                store_tile_bf16(op, o0, h); store_tile_bf16(op + 32, o1, h);
                if (h == 0) { f32x2 ml = {m, lt}; *(f32x2*)(MLP + (((size_t)pt * T + tq) * 8 + hh) * 2) = ml; }
                if (!has_next) break;
                tb = ntb; j0 = nj0; dsh = ndsh; hh = nhh; pt = npt; task = ntask;
#pragma unroll
                for (int s_ = 0; s_ < 4; ++s_) qf[s_] = qfn[s_];
#pragma unroll
                for (int r = 0; r < 16; ++r) { o0[r] = 0.f; o1[r] = 0.f; }
                m = NEG; l = 0.f;
            }
            kt = nkt;
        }
    }
#undef DIL_DECODE
#undef DIL_LOADQ
#undef DIL_LOADKV
    }
}

DI void p3_attention(Frame& F) {
    Xpose X; X.next = F.gw; X.cur = 0; X.pend = false; X.tick = 0;
    X.w1 = in_ptr<IN_W1>(); X.w3 = in_ptr<IN_W3>(); X.w2 = in_ptr<IN_W2>(); X.s1 = in_ptr<IN_WS1>(); X.s3 = in_ptr<IN_WS3>(); X.s2 = in_ptr<IN_WS2>();
#pragma unroll
    for (int i = 0; i < 16; ++i) X.v[i] = (f32x4){0.f, 0.f, 0.f, 0.f};
    for (int rep = 0; rep < REP_MLA; ++rep) mla_phase(F, X);
    while (X.pend || X.next < XP_TILES) xpose_step<1>(F, X);
    asm volatile("s_waitcnt vmcnt(0) lgkmcnt(0)" ::: "memory"); __syncthreads();
    for (int rep = 0; rep < REP_DIL; ++rep) swa_stream(F);
}

DI void p3b_merge(Frame& F) {
    unsigned char* ws = F.ws;
    const bf16* ODP = (const bf16*)((unsigned char*)F.out + DO_ODP); const float* MLP = (const float*)((unsigned char*)F.out + DO_MLP);
    bf16* Y = (bf16*)(ws + WS_Y); const float* SSQO = (const float*)(ws + WS_SSQO);
    const int gt = blockIdx.x * 512 + ((int)threadIdx.x), ngt = gridDim.x * 512;
    for (int idx0 = gt; idx0 < T * 64; idx0 += 4 * ngt) {
        u32x4 v[4][3]; f32x2 ml[4][3]; f32x4 sa[4], sb[4];
#pragma unroll
        for (int q = 0; q < 4; ++q) { int idx = idx0 + q * ngt; idx = idx < T * 64 ? idx : idx0; const int dg = idx & 7, hh = (idx >> 3) & 7; const size_t t = (size_t)(idx >> 6);
            sa[q] = *(const f32x4*)(SSQO + t * 16 + 8); sb[q] = *(const f32x4*)(SSQO + t * 16 + 12);
#pragma unroll
            for (int p = 0; p < 3; ++p) { ml[q][p] = *(const f32x2*)(MLP + (((size_t)p * T + t) * 8 + hh) * 2); v[q][p] = *(const u32x4*)(ODP + ((size_t)p * T + t) * 512 + hh * 64 + dg * 8); } }
#pragma unroll
        for (int q = 0; q < 4; ++q) { const int idx = idx0 + q * ngt; if (idx >= T * 64) break; const int dg = idx & 7, hh = (idx >> 3) & 7; const size_t t = (size_t)(idx >> 6);
            const float M = fmaxf(ml[q][0][0], fmaxf(ml[q][1][0], ml[q][2][0]));
            float w[3], wsum = 0.f;
#pragma unroll
            for (int p = 0; p < 3; ++p) { w[p] = ml[q][p][1] * __builtin_amdgcn_exp2f(ml[q][p][0] - M); wsum += w[p]; }
            const float inv = 1.0f / wsum;
            float o[8];
#pragma unroll
            for (int i = 0; i < 8; ++i) o[i] = 0.f;
#pragma unroll
            for (int p = 0; p < 3; ++p) { const float wp = w[p] * inv; const unsigned a = v[q][p][0], b = v[q][p][1], c = v[q][p][2], d = v[q][p][3];
                o[0] += wp * __uint_as_float(a << 16); o[1] += wp * __uint_as_float(a & 0xffff0000u);
                o[2] += wp * __uint_as_float(b << 16); o[3] += wp * __uint_as_float(b & 0xffff0000u);
                o[4] += wp * __uint_as_float(c << 16); o[5] += wp * __uint_as_float(c & 0xffff0000u);
                o[6] += wp * __uint_as_float(d << 16); o[7] += wp * __uint_as_float(d & 0xffff0000u); }
            float ssq = 0.f;
#pragma unroll
            for (int i = 0; i < 8; ++i) ssq += o[i] * o[i];
            ssq = wave_sum(ssq);
            u32x4 w4; w4.x = pk2(o[0], o[1]); w4.y = pk2(o[2], o[3]); w4.z = pk2(o[4], o[5]); w4.w = pk2(o[6], o[7]);
            *(u32x4*)(Y + t * 1024 + hh * 64 + dg * 8) = w4;
            if ((idx & 63) == 0) { const f32x4 a = sa[q], b = sb[q];
                const float rd = 1.0f / sqrtf(ssq * (1.0f / 512.0f) + RMS_EPS), rm = 1.0f / sqrtf((((a.x + a.y) + (a.z + a.w)) + ((b.x + b.y) + (b.z + b.w))) * (1.0f / 512.0f) + RMS_EPS);
                f32x2 r2 = {rd / rm, rm}; *(f32x2*)((float*)(ws + WS_RDRM) + t * 2) = r2; }
        }
    }
}

DI void ln1_row(const float* xr, const bf16* mr, bf16* dstb, const float* g, const float* b, int lane) {
    f32x4 v[4]; float s = 0.f;
#pragma unroll
    for (int j = 0; j < 4; ++j) { const f32x4 xv = *(const f32x4*)(xr + 4 * lane + 256 * j); const u32x2 mv = *(const u32x2*)(mr + 4 * lane + 256 * j);
        v[j].x = ALPHA * xv.x + __uint_as_float(mv[0] << 16); v[j].y = ALPHA * xv.y + __uint_as_float(mv[0] & 0xffff0000u);
        v[j].z = ALPHA * xv.z + __uint_as_float(mv[1] << 16); v[j].w = ALPHA * xv.w + __uint_as_float(mv[1] & 0xffff0000u);
        s += (v[j].x + v[j].y) + (v[j].z + v[j].w); }
    const float mean = wave_sum(s) * (1.f / 1024.f); float s2 = 0.f;
#pragma unroll
    for (int j = 0; j < 4; ++j) { v[j] = v[j] - mean; s2 += (v[j].x * v[j].x + v[j].y * v[j].y) + (v[j].z * v[j].z + v[j].w * v[j].w); }
    const float rstd = 1.f / sqrtf(wave_sum(s2) * (1.f / 1024.f) + LN_EPS);
#pragma unroll
    for (int j = 0; j < 4; ++j) { const f32x4 gg = *(const f32x4*)(g + 4 * lane + 256 * j), bb = *(const f32x4*)(b + 4 * lane + 256 * j);
        f32x4 o = v[j] * rstd * gg + bb;
        u32x2 w; w.x = pk2(o.x, o.y); w.y = pk2(o.z, o.w); *(u32x2*)(dstb + 4 * lane + 256 * j) = w; }
}
DI void p5a_rows(Frame& F, int row0) {
    bf16* H1B = (bf16*)F.out; const bf16* MIXB = (const bf16*)(F.ws + WS_MIXB); const float* g1 = in_ptr<IN_LN1G>(); const float* b1 = in_ptr<IN_LN1B>(); const float* x = in_ptr<IN_X>();
    for (int row = row0 + F.wave; row < row0 + 256; row += 8) ln1_row(x + (size_t)row * 1024, MIXB + (size_t)row * 1024, H1B + (size_t)row * H1_LD, g1, b1, ((int)threadIdx.x & 63));
}
DI void p5a_ln1(Frame& F) {
    bf16* H1B = (bf16*)F.out; const bf16* MIXB = (const bf16*)(F.ws + WS_MIXB); const float* g1 = in_ptr<IN_LN1G>(); const float* b1 = in_ptr<IN_LN1B>(); const float* x = in_ptr<IN_X>();
    for (int row = F.gw; row < T; row += F.ngw) ln1_row(x + (size_t)row * 1024, MIXB + (size_t)row * 1024, H1B + (size_t)row * H1_LD, g1, b1, ((int)threadIdx.x & 63));
}
DI void wg_handoff() { asm volatile("s_waitcnt vmcnt(0)" ::: "memory"); __syncthreads(); __builtin_amdgcn_fence(__ATOMIC_ACQUIRE, "agent"); asm volatile("s_waitcnt vmcnt(0)" ::: "memory"); __syncthreads(); }
DI void p5_chain(Frame& F) {
    DenseSched S; S.init(T, 256, 1024, (const bf16*)(F.ws + WS_W_R), gridDim.x, blockIdx.x);
    pg::Unit u; if (!S.next(0, u)) return;
    const int blk = u.pm;
    p5a_rows(F, blk * 256);
    wg_handoff();
    { EpiRouter E{(float*)(F.ws + WS_LOGITS)}; pg::gemm_phase<EpiRouter, DenseSched>(F.lds, (const char*)F.out, H1_LD, 1024, S, E); }
    wg_handoff();
    p5c_route(F, blk * 256, blk * 256 + 256, 128);
}
DI f32x4 bf4(const u32x2 v) { f32x4 r; r.x = __uint_as_float(v[0] << 16); r.y = __uint_as_float(v[0] & 0xffff0000u); r.z = __uint_as_float(v[1] << 16); r.w = __uint_as_float(v[1] & 0xffff0000u); return r; }
DI void p9_combine(Frame& F) {
    unsigned char* ws = F.ws;
    const unsigned char* Y2 = (const unsigned char*)(ws + WS_Y2C); const unsigned* POSC = (const unsigned*)(ws + WS_RANK); const bf16* SHB = (const bf16*)F.out + 1024; const float* g2 = in_ptr<IN_LN2G>(); const float* b2 = in_ptr<IN_LN2B>();
    const int lane = ((int)threadIdx.x & 63);
    u32x4 pa = {0u, 0u, 0u, 0u}, pb = {0u, 0u, 0u, 0u};
    if (F.gw < T) { pa = *(const u32x4*)(POSC + (size_t)F.gw * 8); pb = *(const u32x4*)(POSC + (size_t)F.gw * 8 + 4); }
    for (int row = F.gw; row < T; row += F.ngw) {
        u32x4 na = pa, nb = pb;
        { const int nrow = row + F.ngw < T ? row + F.ngw : row; na = *(const u32x4*)(POSC + (size_t)nrow * 8); nb = *(const u32x4*)(POSC + (size_t)nrow * 8 + 4); }
        u32x4 v[8];
#pragma unroll
        for (int k = 0; k < 8; ++k) v[k] = *(const u32x4*)(Y2 + (size_t)(k < 4 ? pa[k] : pb[k - 4]) * 1024 + 16 * lane);
        float* zr = F.out + (size_t)row * 1024 + 16 * lane; const bf16* sr = SHB + (size_t)row * H1_LD + 16 * lane;
        const u32x4 sh0 = *(const u32x4*)sr, sh1 = *(const u32x4*)(sr + 8);
        f32x4 x[4];
        { const bf16* hr = (const bf16*)F.out + (size_t)row * H1_LD + 16 * lane; const u32x4 h0 = *(const u32x4*)hr, h1v = *(const u32x4*)(hr + 8);
          u32x2 t0, t1, t2, t3; t0[0] = h0[0]; t0[1] = h0[1]; t1[0] = h0[2]; t1[1] = h0[3]; t2[0] = h1v[0]; t2[1] = h1v[1]; t3[0] = h1v[2]; t3[1] = h1v[3];
          x[0] = bf4(t0); x[1] = bf4(t1); x[2] = bf4(t2); x[3] = bf4(t3); }
        f32x4 s[4];
#pragma unroll
        for (int j = 0; j < 4; ++j) s[j] = (f32x4){0.f, 0.f, 0.f, 0.f};
#pragma unroll
        for (int k = 0; k < 8; ++k)
#pragma unroll
            for (int j = 0; j < 4; ++j) { const f32x2 a = __builtin_amdgcn_cvt_pk_f32_fp8((int)v[k][j], false), b = __builtin_amdgcn_cvt_pk_f32_fp8((int)v[k][j], true);
                s[j].x += a[0]; s[j].y += a[1]; s[j].z += b[0]; s[j].w += b[1]; }
        { u32x2 t0, t1, t2, t3; t0[0] = sh0[0]; t0[1] = sh0[1]; t1[0] = sh0[2]; t1[1] = sh0[3]; t2[0] = sh1[0]; t2[1] = sh1[1]; t3[0] = sh1[2]; t3[1] = sh1[3];
          x[0] = x[0] * ALPHA + s[0] * (1.0f / Y2_SCALE) + bf4(t0); x[1] = x[1] * ALPHA + s[1] * (1.0f / Y2_SCALE) + bf4(t1);
          x[2] = x[2] * ALPHA + s[2] * (1.0f / Y2_SCALE) + bf4(t2); x[3] = x[3] * ALPHA + s[3] * (1.0f / Y2_SCALE) + bf4(t3); }
        float sm = 0.f;
#pragma unroll
        for (int j = 0; j < 4; ++j) sm += (x[j].x + x[j].y) + (x[j].z + x[j].w);
        const float mean = wave_sum(sm) * (1.f / 1024.f); float s2 = 0.f;
#pragma unroll
        for (int j = 0; j < 4; ++j) { x[j] = x[j] - mean; s2 += (x[j].x * x[j].x + x[j].y * x[j].y) + (x[j].z * x[j].z + x[j].w * x[j].w); }
        const float rstd = 1.f / sqrtf(wave_sum(s2) * (1.f / 1024.f) + LN_EPS);
        const float* gp = g2 + 16 * lane; const float* bp = b2 + 16 * lane;
#pragma unroll
        for (int j = 0; j < 4; ++j) *(f32x4*)(zr + 4 * j) = x[j] * rstd * *(const f32x4*)(gp + 4 * j) + *(const f32x4*)(bp + 4 * j);
        pa = na; pb = nb;
    }
}

struct Args { const float* in[21]; float* out; unsigned char* ws; int ph_lo, ph_hi; };
constexpr int NPHASE = 13;

__global__ void __launch_bounds__(512, 2) mk_fwd(Args args) {
    extern __shared__ __attribute__((aligned(16))) unsigned char lds[];
    Frame F;
    F.lds = (LAS unsigned char*)lds;
    F.wave = __builtin_amdgcn_readfirstlane((int)threadIdx.x >> 6);
    F.gw = blockIdx.x * 8 + F.wave; F.ngw = gridDim.x * 8;
    F.out = args.out; F.ws = args.ws;
    volatile LAS unsigned* misc = (volatile LAS unsigned*)(F.lds + LDS_MISC);
    if (((int)threadIdx.x) < 4) misc[((int)threadIdx.x)] = 0u;
    __syncthreads();
    XcdBarrier bar = xcd_barrier_post((unsigned*)(F.ws + WS_CTL) + CW_BAR, misc);
    const int lo = args.ph_lo, hi = args.ph_hi;
#define IN(k) (lo <= (k) && (k) < hi)
#define SEAM(k) do { if (IN(k) && IN((k) + 1)) xcd_barrier(bar); } while (0)
    if (IN(0)) for (int rep = 0; rep < REP_P0; ++rep) p0_prologue(F);
    SEAM(0);
    if (IN(1)) for (int rep = 0; rep < REP_P1; ++rep) p1_proj(F);
    SEAM(1);
    if (IN(2)) for (int rep = 0; rep < REP_P2; ++rep) p2_up(F);
    SEAM(2);
    if (IN(3)) p3_attention(F);
    SEAM(3);
    if (IN(4)) p3b_merge(F);
    SEAM(4);
    if (IN(5)) for (int rep = 0; rep < REP_P4; ++rep) p4_wo(F);
    SEAM(5);
    const bool chain5 = (int)gridDim.x * 256 == T;
    if (IN(6)) { if (chain5) p5_chain(F); else p5a_ln1(F); }
    if (!chain5) SEAM(6);
    if (IN(7) && !chain5) p5b_router(F);
    if (!chain5) SEAM(7);
    if (IN(8) && !chain5) p5c_route(F);
    SEAM(8);
    if (IN(9)) p6_scatter(F);
    SEAM(9);
    if (IN(10)) for (int rep = 0; rep < REP_P7; ++rep) p7_gemm1(F);
    SEAM(10);
    if (IN(11)) { p8_gemm2_v2<0>(F); if (REP_P8 > 1) p8_gemm2_v2<REP_P8 - 1>(F); p8s_shared2(F); }
    SEAM(11);
    if (IN(12)) p9_combine(F);
#undef IN
#undef SEAM
}

#ifndef MK_N_LAUNCHES
#define MK_N_LAUNCHES 1
#endif

extern "C" void kernel_launch(void* const* d_in, const int* in_sizes, int n_in, void* d_out, int out_size, void* d_ws, size_t ws_size, hipStream_t stream) {
    static int grid = 0;
    if (grid == 0) {
        if (n_in != 21 || out_size != T * DM || ws_size < WS_NEED) { fprintf(stderr, "kernel_launch: unexpected shapes (n_in %d out %d ws %zu)\n", n_in, out_size, ws_size); grid = -1; return; }
        int dev = 0, cus = 0, per_cu = 0;
        if (hipGetDevice(&dev) != hipSuccess || hipDeviceGetAttribute(&cus, hipDeviceAttributeMultiprocessorCount, dev) != hipSuccess) { grid = -1; return; }
        if (hipFuncSetAttribute((const void*)mk_fwd, hipFuncAttributeMaxDynamicSharedMemorySize, LDS_BYTES) != hipSuccess) { fprintf(stderr, "kernel_launch: hipFuncSetAttribute failed\n"); grid = -1; return; }
        if (hipOccupancyMaxActiveBlocksPerMultiprocessor(&per_cu, (const void*)mk_fwd, 512, LDS_BYTES) != hipSuccess || per_cu < 1) { fprintf(stderr, "kernel_launch: occupancy query says %d\n", per_cu); }
        (void)hipGetLastError();
        grid = cus;
    }
    if (grid < 0) return;
    (void)hipMemsetAsync((char*)d_ws + WS_CTL, 0, CTL_BYTES, stream);
    Args a{};
    for (int i = 0; i < 21; ++i) a.in[i] = (const float*)d_in[i];
    a.out = (float*)d_out; a.ws = (unsigned char*)d_ws;
#if MK_N_LAUNCHES == 1
    a.ph_lo = 0; a.ph_hi = NPHASE;
    hipLaunchKernelGGL(mk_fwd, dim3(grid), dim3(512), LDS_BYTES, stream, a);
#else
    for (int p = 0; p < NPHASE; ++p) { a.ph_lo = p; a.ph_hi = p + 1; hipLaunchKernelGGL(mk_fwd, dim3(grid), dim3(512), LDS_BYTES, stream, a); }
#endif
}
```
